# Optimizing an MI355X kernel written in HIP

```python
import jax, jax.numpy as jnp
from jax import lax
import numpy as np

D_MODEL = 1024
BATCH = 16
SEQ = 4096
DEPTH = 2

CHUNK = 64
CONV_WIDTH = 4
A_HEADS = 4
A_DK = 64
A_DV = 64
B_HEADS = 4
B_DK = 48
B_DV = 96
GLA_RANK = 16
GLA_GATE_TEMP = 16.0
C_HEADS = 6
C_DK = 64
C_DV = 64

A_QK = A_HEADS * A_DK
A_V = A_HEADS * A_DV
B_QK = B_HEADS * B_DK
B_V = B_HEADS * B_DV
C_QK = C_HEADS * C_DK
C_V = C_HEADS * C_DV
C_QKV = 2 * C_QK + C_V
D_MIX = A_V + B_V + C_V
SPLIT_SIZES = (A_QK, A_QK, A_V, A_V, B_QK, B_QK, B_V, GLA_RANK, B_V, C_QKV, C_HEADS, C_HEADS, C_V)
D_IN = A_QK * 2 + A_V * 2 + B_QK * 2 + B_V * 2 + GLA_RANK + C_QKV + 2 * C_HEADS + C_V

DEEPNORM_ALPHA = (2 * DEPTH) ** 0.25
DEEPNORM_BETA = (8 * DEPTH) ** -0.25
LN_EPS = 1e-5
NORM_EPS = 1e-6
FORGET_FLOOR = 1e-30

kernel_name = 'hybrid_hgrn2_gla_gdn_streaming_layer'


def _layer_norm(x):
    x32 = x.astype(jnp.float32)
    mu = jnp.mean(x32, axis=-1, keepdims=True)
    var = jnp.mean(jnp.square(x32 - mu), axis=-1, keepdims=True)
    return (x32 - mu) * lax.rsqrt(var + LN_EPS)


def _head_rmsnorm(o, gain):
    return o * lax.rsqrt(jnp.mean(o * o, axis=-1, keepdims=True) + NORM_EPS) * gain.astype(jnp.float32)


def _l2norm(t):
    return t * lax.rsqrt(jnp.sum(t * t, axis=-1, keepdims=True) + NORM_EPS)


def _causal_depthwise_conv(x, w):
    s = x.shape[1]
    xp = jnp.pad(x, ((0, 0), (CONV_WIDTH - 1, 0), (0, 0)))
    return sum(xp[:, j:j + s] * w[j] for j in range(CONV_WIDTH))


def _chunk(t):
    b, s, h, d = t.shape
    return t.reshape(b, s // CHUNK, CHUNK, h, d).transpose(1, 0, 3, 2, 4)


def _unchunk(t):
    n, b, h, c, d = t.shape
    return t.transpose(1, 0, 3, 2, 4).reshape(b, n * c, h, d)


def _masked_decay(rel, mask):
    return jnp.where(mask, jnp.exp(jnp.where(mask, rel, 0.0)), 0.0)


def _gla_chunked(q, k, v, log_g):
    qc, kc, vc, gc = _chunk(q), _chunk(k), _chunk(v), _chunk(log_g)
    causal = jnp.tril(jnp.ones((CHUNK, CHUNK), dtype=bool))[:, :, None]

    def step(state, xs):
        qi, ki, vi, gi = xs
        bcum = jnp.cumsum(gi, axis=-2)
        rel = bcum[..., :, None, :] - bcum[..., None, :, :]
        decay = _masked_decay(rel, causal)
        scores = jnp.sum(qi[..., :, None, :] * ki[..., None, :, :] * decay, axis=-1)
        o = (jnp.einsum('bhts,bhsv->bhtv', scores, vi)
             + jnp.einsum('bhtk,bhkv->bhtv', qi * jnp.exp(bcum), state))
        b_last = bcum[..., -1:, :]
        state = (jnp.exp(b_last[..., 0, :])[..., None] * state
                 + jnp.einsum('bhsk,bhsv->bhkv', ki * jnp.exp(b_last - bcum), vi))
        return state, o

    bsz, _, h, dk = q.shape
    state0 = jnp.zeros((bsz, h, dk, v.shape[-1]), jnp.float32)
    _, o = lax.scan(step, state0, (qc, kc, vc, gc))
    return _unchunk(o)


def _gated_delta_chunked(q, k, v, log_a, beta):
    qc, kc, vc = _chunk(q), _chunk(k), _chunk(v)
    gc = _chunk(log_a[..., None])[..., 0]
    bc = _chunk(beta[..., None])[..., 0]
    bcum = jnp.cumsum(gc, axis=-1)
    causal = jnp.tril(jnp.ones((CHUNK, CHUNK), dtype=bool))
    strict = jnp.tril(jnp.ones((CHUNK, CHUNK), dtype=bool), k=-1)
    rel = bcum[..., :, None] - bcum[..., None, :]
    decay = _masked_decay(rel, causal)
    k_beta = kc * bc[..., None]
    v_beta = vc * bc[..., None]
    lower = jnp.where(strict, jnp.einsum('nbhtk,nbhsk->nbhts', k_beta, kc) * decay, 0.0)
    eye = jnp.eye(CHUNK, dtype=lower.dtype)
    t_inv = lax.linalg.triangular_solve(eye + lower, jnp.broadcast_to(eye, lower.shape),
                                        left_side=True, lower=True, unit_diagonal=True)
    u = jnp.einsum('nbhts,nbhsv->nbhtv', t_inv, v_beta)
    w = jnp.einsum('nbhts,nbhsk->nbhtk', t_inv, k_beta * jnp.exp(bcum)[..., None])
    attn = jnp.where(causal, jnp.einsum('nbhtk,nbhsk->nbhts', qc, kc) * decay, 0.0)

    def step(state, xs):
        qi, ki, ui, wi, bi, ai = xs
        v_new = ui - jnp.einsum('bhtk,bhkv->bhtv', wi, state)
        o = (jnp.einsum('bhtk,bhkv->bhtv', qi * jnp.exp(bi)[..., None], state)
             + jnp.einsum('bhts,bhsv->bhtv', ai, v_new))
        b_last = bi[..., -1:]
        state = (jnp.exp(b_last)[..., None] * state
                 + jnp.einsum('bhsk,bhsv->bhkv', ki * jnp.exp(b_last - bi)[..., None], v_new))
        return state, o

    bsz, _, h, dk = q.shape
    state0 = jnp.zeros((bsz, h, dk, v.shape[-1]), jnp.float32)
    _, o = lax.scan(step, state0, (qc, kc, u, w, bcum, attn))
    return _unchunk(o)


def _hybrid_layer(x, c_act, lb, w_in, w_out, ada_w, ada_b, ln_g, ln_b, gla_w_gk, gla_b_gk,
                  gdn_conv_w, gdn_a_log, gdn_dt_bias, gain_a, gain_b, gain_c):
    bsz, s, _ = x.shape
    f32 = jnp.float32
    mod = (c_act @ ada_w + ada_b).astype(f32)
    shift, scale, gate = jnp.split(mod, 3, axis=-1)
    h = _layer_norm(x) * (1 + scale[:, None, :]) + shift[:, None, :]
    proj = (h.astype(x.dtype) @ w_in).astype(f32)
    offsets = [int(o) for o in np.cumsum(SPLIT_SIZES)[:-1]]
    qa, fa, ia, za, qb, kb, vb, lrb, zb, qkvc, ac, bc, zc = jnp.split(proj, offsets, axis=-1)

    def heads(t, n):
        return t.reshape(bsz, s, n, -1)

    fa_logit = heads(fa, A_HEADS)
    lb_h = lb.astype(f32).reshape(A_HEADS, A_DK)
    f_a = lb_h + (1 - lb_h) * jax.nn.sigmoid(fa_logit)
    log_f = jnp.log(jnp.maximum(f_a, FORGET_FLOOR))
    k_a = (1 - lb_h) * jax.nn.sigmoid(-fa_logit)
    o_a = _gla_chunked(jax.nn.silu(heads(qa, A_HEADS)), k_a, heads(ia, A_HEADS), log_f)

    gk = jax.nn.log_sigmoid(lrb @ gla_w_gk.astype(f32) + gla_b_gk.astype(f32)) / GLA_GATE_TEMP
    o_b = _gla_chunked(heads(qb, B_HEADS) * (B_DK ** -0.5), heads(kb, B_HEADS),
                       heads(vb, B_HEADS), heads(gk, B_HEADS))

    qkvc = jax.nn.silu(_causal_depthwise_conv(qkvc, gdn_conv_w.astype(f32)))
    qc, kc, vc = jnp.split(qkvc, [C_QK, 2 * C_QK], axis=-1)
    qc = _l2norm(heads(qc, C_HEADS)) * (C_DK ** -0.5)
    kc = _l2norm(heads(kc, C_HEADS))
    log_a = -jnp.exp(gdn_a_log.astype(f32)) * jax.nn.softplus(ac + gdn_dt_bias.astype(f32))
    beta = jax.nn.sigmoid(bc)
    o_c = _gated_delta_chunked(qc, kc, heads(vc, C_HEADS), log_a, beta)

    y = jnp.concatenate([
        _head_rmsnorm(o_a, gain_a).reshape(bsz, s, A_V) * jax.nn.silu(za),
        _head_rmsnorm(o_b, gain_b).reshape(bsz, s, B_V) * jax.nn.silu(zb),
        _head_rmsnorm(o_c, gain_c).reshape(bsz, s, C_V) * jax.nn.silu(zc),
    ], axis=-1)
    out = (y.astype(x.dtype) @ w_out).astype(f32)
    res = DEEPNORM_ALPHA * x.astype(f32) + gate[:, None, :] * out
    return (_layer_norm(res) * ln_g.astype(f32) + ln_b.astype(f32)).astype(x.dtype)


def setup_inputs(seed: int = 0) -> dict:
    key = jax.random.key(seed)
    ks = jax.random.split(key, 18)
    d = D_MODEL
    x = jax.random.normal(ks[0], (BATCH, SEQ, d), jnp.float32)
    c = jax.random.normal(ks[1], (BATCH, d), jnp.float32)
    b_ = DEEPNORM_BETA
    seg = [(A_QK, 1.0), (A_QK, 1.0), (A_V, b_), (A_V, 1.0),
           (B_QK, 1.0), (B_QK, 1.0), (B_V, b_), (GLA_RANK, 1.0), (B_V, 1.0),
           (2 * C_QK, 1.0), (C_V, b_), (C_HEADS, 1.0), (C_HEADS, 1.0), (C_V, 1.0)]
    col_scale = jnp.concatenate([jnp.full((n,), sc, jnp.float32) for n, sc in seg])
    w_in = jax.random.normal(ks[2], (DEPTH, d, D_IN), jnp.float32) * (d ** -0.5) * col_scale
    w_out = jax.random.normal(ks[3], (DEPTH, D_MIX, d), jnp.float32) * (D_MIX ** -0.5) * DEEPNORM_BETA
    ada_w = jax.random.normal(ks[4], (DEPTH, d, 3 * d), jnp.float32) * (0.5 * d ** -0.5)
    ada_b = jax.random.normal(ks[5], (DEPTH, 3 * d), jnp.float32) * 0.02
    ln_g = 1.0 + 0.02 * jax.random.normal(ks[6], (DEPTH, d), jnp.float32)
    ln_b = 0.02 * jax.random.normal(ks[7], (DEPTH, d), jnp.float32)
    hgrn_lb_logits = 0.5 * jax.random.normal(ks[8], (DEPTH, A_QK), jnp.float32)
    gla_w_gk = jax.random.normal(ks[9], (DEPTH, GLA_RANK, B_QK), jnp.float32) * (GLA_RANK ** -0.5)
    gla_b_gk = 0.1 * jax.random.normal(ks[10], (DEPTH, B_QK), jnp.float32)
    gdn_conv_w = jax.random.normal(ks[11], (DEPTH, CONV_WIDTH, C_QKV), jnp.float32) * (CONV_WIDTH ** -0.5)
    gdn_a_log = jnp.log(jax.random.uniform(ks[12], (DEPTH, C_HEADS), jnp.float32, 1.0, 16.0))
    dt = jnp.exp(jax.random.uniform(ks[13], (DEPTH, C_HEADS), jnp.float32, float(np.log(1e-3)), float(np.log(1e-1))))
    gdn_dt_bias = dt + jnp.log(-jnp.expm1(-dt))
    gain_a = 1.0 + 0.02 * jax.random.normal(ks[14], (DEPTH, A_DV), jnp.float32)
    gain_b = 1.0 + 0.02 * jax.random.normal(ks[15], (DEPTH, B_DV), jnp.float32)
    gain_c = 1.0 + 0.02 * jax.random.normal(ks[16], (DEPTH, C_DV), jnp.float32)
    return {'x': x, 'c': c, 'w_in': w_in, 'w_out': w_out, 'ada_w': ada_w, 'ada_b': ada_b,
            'ln_g': ln_g, 'ln_b': ln_b, 'hgrn_lb_logits': hgrn_lb_logits,
            'gla_w_gk': gla_w_gk, 'gla_b_gk': gla_b_gk, 'gdn_conv_w': gdn_conv_w,
            'gdn_a_log': gdn_a_log, 'gdn_dt_bias': gdn_dt_bias,
            'gain_a': gain_a, 'gain_b': gain_b, 'gain_c': gain_c}


def reference(x, c, w_in, w_out, ada_w, ada_b, ln_g, ln_b, hgrn_lb_logits, gla_w_gk, gla_b_gk,
              gdn_conv_w, gdn_a_log, gdn_dt_bias, gain_a, gain_b, gain_c):
    c_act = jax.nn.silu(c)
    p = jax.nn.softmax(hgrn_lb_logits.astype(jnp.float32), axis=0)
    lb_table = jnp.cumsum(p, axis=0) - p[0:1]
    for l in range(DEPTH):
        x = _hybrid_layer(x, c_act, lb_table[l], w_in[l], w_out[l], ada_w[l], ada_b[l],
                          ln_g[l], ln_b[l], gla_w_gk[l], gla_b_gk[l], gdn_conv_w[l],
                          gdn_a_log[l], gdn_dt_bias[l], gain_a[l], gain_b[l], gain_c[l])
    return x
```

```cpp
#include <hip/hip_runtime.h>
#include <hip/hip_cooperative_groups.h>
#include <cstdio>
#include <cstdint>
namespace cg = cooperative_groups;
#define MK_ONE_LAUNCH 1
namespace pg8 {
#define PG8_LAS __attribute__((address_space(3)))
typedef unsigned short bf16_t;
typedef short bf16x8 __attribute__((ext_vector_type(8)));
typedef float f32x4 __attribute__((ext_vector_type(4)));
typedef unsigned u32x4 __attribute__((ext_vector_type(4)));
constexpr int BM = 256, BK = 64, HALF = 128, HTB = HALF * BK * 2  , STAGE_BYTES = 8 * HTB, NXCD = 8, WGM = 8;

__host__ __device__ __forceinline__ int lds_byte(int r, int c) { const int st = (r >> 4) * 2 + (c >> 5), rr = r & 15, cc = c & 31, ob = rr * 64 + cc * 2; return st * 1024 + (ob ^ (((ob >> 9) & 1) << 5)); }
__host__ __device__ __forceinline__ void stage_rc(int b, int& R, int& C) { const int st = b / 1024, sb = b % 1024, swz = sb ^ (((sb >> 9) & 1) << 5); R = (st >> 1) * 16 + swz / 64; C = (st & 1) * 32 + (swz % 64) / 2; }
__host__ __device__ __forceinline__ int perm32(int rho) { const int n = rho >> 4, i = rho & 15; return 8 * (i >> 2) + 4 * n + (i & 3); }

struct Unit { int pm, pn; };
struct Gemm { const bf16_t* A; const bf16_t* Bt; int M, N, K; };

struct StaticOrder {
    int nM, nN, nwg, G, c;
    __host__ __device__ void init(int M, int N, int G_, int c_) { nM = M / BM; nN = N / BM; nwg = nM * nN; G = G_; c = c_; }
    __host__ __device__ bool next(int i, Unit& u) const {
        const long L = (long)i * G + c; if (L >= nwg) return false;
        int wgid = (int)L; { const int q = nwg / NXCD, r = nwg % NXCD, xcd = wgid % NXCD, off = wgid / NXCD; wgid = (xcd < r ? xcd * (q + 1) : r * (q + 1) + (xcd - r) * q) + off; }
        const int nig = WGM * nN, gid = wgid / nig, fm = gid * WGM, gsz = (nM - fm) < WGM ? (nM - fm) : WGM;
        u.pm = fm + ((wgid % nig) % gsz); u.pn = (wgid % nig) / gsz; return true;
    }
    __device__ __forceinline__ void a_ready(const Unit&) const {}
    __device__ __forceinline__ void done(const Unit&) const {}
};

__device__ __forceinline__ unsigned cvt_pk_bf16(float lo, float hi) { unsigned r; asm volatile("v_cvt_pk_bf16_f32 %0, %1, %2" : "=v"(r) : "v"(lo), "v"(hi)); return r; }
typedef float f32x2 __attribute__((ext_vector_type(2)));
__device__ __forceinline__ f32x2 gelu_pk(f32x2 v) {
    const f32x2 av = __builtin_elementwise_abs(v), d = av * 0.2316418882f + 1.0f;
    f32x2 t; t.x = __builtin_amdgcn_rcpf(d.x); t.y = __builtin_amdgcn_rcpf(d.y);
    f32x2 q = t * 0.5307027145f + (-0.7265760135f); q = q * t + 0.7107068705f; q = q * t + (-0.142248368f); q = q * t + 0.127414796f; q = q * t;
    const f32x2 s = (v * v) * (-0.72134752044f);
    f32x2 e; e.x = __builtin_amdgcn_exp2f(s.x); e.y = __builtin_amdgcn_exp2f(s.y);
    const f32x2 m = v * (q * e), r = v - m;
    f32x2 o; o.x = v.x < 0.f ? m.x : r.x; o.y = v.y < 0.f ? m.y : r.y; return o;
}

template <int ACT  > struct EpiBf16 {
    static constexpr bool PERM = true, AFTER_DRAIN = false; static_assert(ACT == 0 || ACT == 1, "EpiBf16: ACT is 0 (none) or 1 (gelu_pk)");
    bf16_t* O; int ldc; const float* bias; int split_cols; size_t split_stride; float scale0;
    __device__ __forceinline__ void operator()(const f32x4 (&acc)[2][2][4][2], const Unit& u, int wr, int wc, int fr, int fq) const {
        const int row0 = u.pm * BM + wr * 64 + fr; int colt = u.pn * BM; bf16_t* base = O;
        float sc = 1.f; if (split_cols) { const int t = colt / split_cols; base += (size_t)t * split_stride; colt -= t * split_cols; if (t == 0) sc = scale0; }
        const int col0 = colt + wc * 32 + 8 * fq, bcol0 = u.pn * BM + wc * 32 + 8 * fq;
        f32x4 bv[2][2];
#pragma unroll
        for (int bj = 0; bj < 2; ++bj)
#pragma unroll
            for (int n = 0; n < 2; ++n) bv[bj][n] = bias ? *(const f32x4*)(bias + bcol0 + bj * HALF + 4 * n) : (f32x4){0.f, 0.f, 0.f, 0.f};
#pragma unroll
        for (int ai = 0; ai < 2; ++ai)
#pragma unroll
            for (int m = 0; m < 4; ++m) { bf16_t* rowp = base + (size_t)(row0 + ai * HALF + m * 16) * ldc + col0;
#pragma unroll
                for (int bj = 0; bj < 2; ++bj) { f32x4 v0 = acc[ai][bj][m][0] + bv[bj][0], v1 = acc[ai][bj][m][1] + bv[bj][1];
                    if (ACT == 1) { f32x2 a = gelu_pk((f32x2){v0[0], v0[1]}), b = gelu_pk((f32x2){v0[2], v0[3]}), c = gelu_pk((f32x2){v1[0], v1[1]}), d = gelu_pk((f32x2){v1[2], v1[3]});
                        v0 = (f32x4){a.x, a.y, b.x, b.y}; v1 = (f32x4){c.x, c.y, d.x, d.y}; }
                    v0 = v0 * sc; v1 = v1 * sc; u32x4 w; w.x = cvt_pk_bf16(v0[0], v0[1]); w.y = cvt_pk_bf16(v0[2], v0[3]); w.z = cvt_pk_bf16(v1[0], v1[1]); w.w = cvt_pk_bf16(v1[2], v1[3]);
                    *(u32x4*)(rowp + bj * HALF) = w; } }
    }
};

struct PanelStats {
    unsigned* xbuf;
    unsigned* cnt;
    unsigned* tmo;
    int ntn; float eps;
    unsigned code;
    __device__ __forceinline__ bool run(const f32x4 (&v)[2][2][4][2], const Unit& u, int wr, int wc, int fr, int fq, PG8_LAS unsigned char* lds, int wid, int lane) const {
        typedef float f32x2v __attribute__((ext_vector_type(2)));
        PG8_LAS f32x2v* P = (PG8_LAS f32x2v*)lds;
        PG8_LAS f32x2v* S = (PG8_LAS f32x2v*)(lds + 8192);
        PG8_LAS unsigned* flag = (PG8_LAS unsigned*)(lds + 8192 + 2048);
#pragma unroll
        for (int ai = 0; ai < 2; ++ai)
#pragma unroll
            for (int m = 0; m < 4; ++m) {
                float s = 0.f;
#pragma unroll
                for (int bj = 0; bj < 2; ++bj)
#pragma unroll
                    for (int n = 0; n < 2; ++n) { const f32x4 x = v[ai][bj][m][n]; s += (x[0] + x[1]) + (x[2] + x[3]); }
                s += __shfl_xor(s, 16); s += __shfl_xor(s, 32);
                const float mw = s * (1.0f / 64.0f); float q = 0.f;
#pragma unroll
                for (int bj = 0; bj < 2; ++bj)
#pragma unroll
                    for (int n = 0; n < 2; ++n) { const f32x4 d = v[ai][bj][m][n] - mw; q += (d[0] * d[0] + d[1] * d[1]) + (d[2] * d[2] + d[3] * d[3]); }
                q += __shfl_xor(q, 16); q += __shfl_xor(q, 32);
                if (fq == 0) P[(ai * HALF + wr * 64 + m * 16 + fr) * 4 + wc] = (f32x2v){mw, q};
            }
        asm volatile("s_waitcnt lgkmcnt(0)" ::: "memory"); __builtin_amdgcn_s_barrier(); asm volatile("" ::: "memory");
#if defined(BROKEN_EXCHANGE_NO_WAIT)
#warning BROKEN CONTROL BUILD: the row-statistics exchange does not wait; results are wrong by design
        if (blockIdx.x >= 64) { const long long t0_ = clock64(); while (clock64() - t0_ < 60000) __builtin_amdgcn_s_sleep(8); }
#endif
        const int row = wid * 32 + (lane & 31);
        if (lane < 32) {
            const f32x2v a = P[row * 4 + 0], b = P[row * 4 + 1], c = P[row * 4 + 2], d = P[row * 4 + 3];
            const float mt = (a.x + b.x + c.x + d.x) * 0.25f;
            const float da = a.x - mt, db = b.x - mt, dc = c.x - mt, dd = d.x - mt;
            const float m2 = (a.y + b.y) + (c.y + d.y) + 64.0f * ((da * da + db * db) + (dc * dc + dd * dd));
            unsigned long long* slot = (unsigned long long*)xbuf + ((size_t)(u.pm * BM + row) * 4 + u.pn);
            __hip_atomic_store(slot, ((unsigned long long)__float_as_uint(m2) << 32) | __float_as_uint(mt), __ATOMIC_RELAXED, __HIP_MEMORY_SCOPE_AGENT);
        }
        asm volatile("s_waitcnt vmcnt(0)" ::: "memory");
        if (lane == 0) __hip_atomic_fetch_add(cnt + 64 * u.pm, 1u, __ATOMIC_RELAXED, __HIP_MEMORY_SCOPE_AGENT);
        if (wid == 0) {
            bool dead = false; const unsigned long long t0 = __builtin_amdgcn_s_memrealtime(); const unsigned want = 8u * (unsigned)ntn;
            for (;;) {
#if defined(BROKEN_EXCHANGE_NO_WAIT)
                break;
#endif
                if ((unsigned)__builtin_amdgcn_readfirstlane(__hip_atomic_load(cnt + 64 * u.pm, __ATOMIC_RELAXED, __HIP_MEMORY_SCOPE_AGENT)) >= want) break;
                if (__builtin_amdgcn_s_memrealtime() - t0 > 2000000ull) {
                    if (lane == 0) { unsigned expect = 0u; __hip_atomic_compare_exchange_strong(tmo + 1, &expect, code | (unsigned)(u.pm & 0xff), __ATOMIC_RELAXED, __ATOMIC_RELAXED, __HIP_MEMORY_SCOPE_AGENT);
                                     __hip_atomic_store(tmo, 1u, __ATOMIC_RELAXED, __HIP_MEMORY_SCOPE_AGENT); }
                    dead = true; break; }
                __builtin_amdgcn_s_sleep(2);
            }
            __builtin_amdgcn_fence(__ATOMIC_ACQUIRE, "agent");
            if (lane == 0) flag[0] = dead ? 1u : 0u;
        }
        asm volatile("s_waitcnt vmcnt(0) lgkmcnt(0)" ::: "memory"); __builtin_amdgcn_s_barrier(); asm volatile("" ::: "memory");
        const bool bad = flag[0] != 0u;
        if (lane < 32) {
            const unsigned long long* slot = (const unsigned long long*)xbuf + (size_t)(u.pm * BM + row) * 4; float mt[4], m2[4]; float ms = 0.f;
#pragma unroll
            for (int t = 0; t < 4; ++t) { if (t < ntn) { const unsigned long long w = __hip_atomic_load(slot + t, __ATOMIC_RELAXED, __HIP_MEMORY_SCOPE_AGENT); mt[t] = __uint_as_float((unsigned)w); m2[t] = __uint_as_float((unsigned)(w >> 32)); } else { mt[t] = 0.f; m2[t] = 0.f; } ms += mt[t]; }
            const float mean = ms / (float)ntn; float q = 0.f;
#pragma unroll
            for (int t = 0; t < 4; ++t) if (t < ntn) { const float dm = mt[t] - mean; q += m2[t] + 256.0f * dm * dm; }
            S[row] = (f32x2v){mean, 1.0f / sqrtf(q / (256.0f * (float)ntn) + eps)};
        }
        asm volatile("s_waitcnt lgkmcnt(0)" ::: "memory"); __builtin_amdgcn_s_barrier(); asm volatile("" ::: "memory");
        return bad;
    }
};
struct EpiLnRes {
    static constexpr bool PERM = false, AFTER_DRAIN = true;
    const float* base; float* out; int ldc; const float* bias; PanelStats st; unsigned poison;
    __device__ __forceinline__ void fused(f32x4 (&acc)[2][2][4][2], const Unit& u, int wr, int wc, int fr, int fq, PG8_LAS unsigned char* lds, int wid, int lane) const {
        typedef float f32x2v __attribute__((ext_vector_type(2)));
        const PG8_LAS f32x2v* S = (const PG8_LAS f32x2v*)(lds + 8192);
        const int col0 = u.pn * BM + wc * 32 + 4 * fq;
#pragma unroll
        for (int bj = 0; bj < 2; ++bj)
#pragma unroll
            for (int n = 0; n < 2; ++n) { const f32x4 bv = bias ? *(const f32x4*)(bias + col0 + bj * HALF + n * 16) : (f32x4){0.f, 0.f, 0.f, 0.f};
#pragma unroll
                for (int ai = 0; ai < 2; ++ai)
#pragma unroll
                    for (int m = 0; m < 4; ++m) acc[ai][bj][m][n] += bv; }
        f32x4 pre[4][2][2];
#pragma unroll
        for (int m = 0; m < 4; ++m) { const size_t off = (size_t)(u.pm * BM + wr * 64 + m * 16 + fr) * ldc + col0;
#pragma unroll
            for (int bj = 0; bj < 2; ++bj)
#pragma unroll
                for (int n = 0; n < 2; ++n) pre[m][bj][n] = *(const f32x4*)(base + off + bj * HALF + n * 16); }
        const bool bad = st.run(acc, u, wr, wc, fr, fq, lds, wid, lane) || poison != 0u;
        const float qnan = __builtin_nanf("");
#pragma unroll
        for (int ai = 0; ai < 2; ++ai)
#pragma unroll
            for (int m = 0; m < 4; ++m) { const int r = ai * HALF + wr * 64 + m * 16 + fr; const f32x2v sr = S[r]; const size_t off = (size_t)(u.pm * BM + r) * ldc + col0;
#pragma unroll
                for (int bj = 0; bj < 2; ++bj)
#pragma unroll
                    for (int n = 0; n < 2; ++n) { const f32x4 bs = ai == 0 ? pre[m][bj][n] : *(const f32x4*)(base + off + bj * HALF + n * 16); f32x4 o = bs + (acc[ai][bj][m][n] - sr.x) * sr.y;
                        if (bad) o = (f32x4){qnan, qnan, qnan, qnan}; *(f32x4*)(out + off + bj * HALF + n * 16) = o; }
                if (m & 1) asm volatile("" ::: "memory"); }
    }
};
struct EpiLnResLn {
    static constexpr bool PERM = false, AFTER_DRAIN = true;
    const float* base; float* out; bf16_t* xn; int ldc; const float* bias; PanelStats st1, st2; unsigned poison;
    __device__ __forceinline__ void fused(f32x4 (&acc)[2][2][4][2], const Unit& u, int wr, int wc, int fr, int fq, PG8_LAS unsigned char* lds, int wid, int lane) const {
        typedef float f32x2v __attribute__((ext_vector_type(2))); typedef unsigned u32x2v __attribute__((ext_vector_type(2)));
        const PG8_LAS f32x2v* S = (const PG8_LAS f32x2v*)(lds + 8192);
        const int col0 = u.pn * BM + wc * 32 + 4 * fq;
#pragma unroll
        for (int bj = 0; bj < 2; ++bj)
#pragma unroll
            for (int n = 0; n < 2; ++n) { const f32x4 bv = bias ? *(const f32x4*)(bias + col0 + bj * HALF + n * 16) : (f32x4){0.f, 0.f, 0.f, 0.f};
#pragma unroll
                for (int ai = 0; ai < 2; ++ai)
#pragma unroll
                    for (int m = 0; m < 4; ++m) acc[ai][bj][m][n] += bv; }
        bool bad = st1.run(acc, u, wr, wc, fr, fq, lds, wid, lane) || poison != 0u;
        const float qnan = __builtin_nanf("");
#pragma unroll
        for (int ai = 0; ai < 2; ++ai)
#pragma unroll
            for (int m = 0; m < 4; ++m) { const int r = ai * HALF + wr * 64 + m * 16 + fr; const f32x2v sr = S[r]; const size_t off = (size_t)(u.pm * BM + r) * ldc + col0;
#pragma unroll
                for (int bj = 0; bj < 2; ++bj)
#pragma unroll
                    for (int n = 0; n < 2; ++n) { const f32x4 bs = *(const f32x4*)(base + off + bj * HALF + n * 16); acc[ai][bj][m][n] = bs + (acc[ai][bj][m][n] - sr.x) * sr.y; }
                asm volatile("" : "+v"(acc[ai][0][m][0]), "+v"(acc[ai][0][m][1]), "+v"(acc[ai][1][m][0]), "+v"(acc[ai][1][m][1]));
                if (m & 1) asm volatile("" ::: "memory"); }
        const bool bad1 = bad;
        bad = st2.run(acc, u, wr, wc, fr, fq, lds, wid, lane) || bad;
#pragma unroll
        for (int ai = 0; ai < 2; ++ai)
#pragma unroll
            for (int m = 0; m < 4; ++m) { const int r = ai * HALF + wr * 64 + m * 16 + fr; const f32x2v sr = S[r]; const size_t off = (size_t)(u.pm * BM + r) * ldc + col0;
#pragma unroll
                for (int bj = 0; bj < 2; ++bj)
#pragma unroll
                    for (int n = 0; n < 2; ++n) { const f32x4 x1 = acc[ai][bj][m][n]; *(f32x4*)(out + off + bj * HALF + n * 16) = bad1 ? (f32x4){qnan, qnan, qnan, qnan} : x1;
                        const f32x4 o = (x1 - sr.x) * sr.y; u32x2v w; w.x = cvt_pk_bf16(o[0], o[1]); w.y = cvt_pk_bf16(o[2], o[3]);
                        if (bad) { w.x = 0x7fc07fc0u; w.y = 0x7fc07fc0u; } *(u32x2v*)(xn + off + bj * HALF + n * 16) = w; }
                asm volatile("" ::: "memory"); }
    }
};

template <class Epi, class Sched, bool ALIGN_EPI = false, bool SP2 = false>
__device__ __forceinline__ void gemm_phase(PG8_LAS unsigned char* lds, const Gemm g, const Sched& S, const Epi& E) {
    int tid_ = threadIdx.x; asm volatile("" : "+v"(tid_));
    const int tid = tid_, wid = __builtin_amdgcn_readfirstlane(tid >> 6), lane = tid & 63, wr = wid >> 2, wc = wid & 3, fr = lane & 15, fq = lane >> 4;
    const int K = g.K, nt = K / BK;
    unsigned voffA[2], voffB[2];
#pragma unroll
    for (int i = 0; i < 2; ++i) { int R, C; stage_rc(tid * 16 + i * 8192, R, C); const int Rb = Epi::PERM ? ((R & ~31) + perm32(R & 31)) : R;
        voffA[i] = (unsigned)(R * K + C) * 2u; voffB[i] = (unsigned)(Rb * K + C) * 2u; }
    const size_t kstep = (size_t)(BK * 2);
    const size_t hstep = (size_t)HALF * K * 2;
    const size_t tstep = 2 * hstep;
    const unsigned ldsw = (unsigned)wid * 1024u;
    const int aoff = lds_byte(wr * 64 + fr, fq * 8), boff = lds_byte(wc * 32 + fr, fq * 8);
#define PG8_SA(b, h) (((b) * 2 + (h)) * HTB)
#define PG8_SB(b, h) ((4 + (b) * 2 + (h)) * HTB)
#define PG8_STAGE(bufoff, gbase, voff) do { _Pragma("unroll") for (int _i = 0; _i < 2; ++_i) \
        __builtin_amdgcn_global_load_lds((const unsigned*)((const char*)(gbase) + (voff)[_i]), (PG8_LAS unsigned*)(lds + (bufoff) + ldsw + _i * 8192), 16, 0, 0); } while (0)
#define PG8_LDA(dst, b, h) do { _Pragma("unroll") for (int m = 0; m < 4; ++m) _Pragma("unroll") for (int k = 0; k < 2; ++k) dst[m][k] = *(const PG8_LAS bf16x8*)(lds + PG8_SA(b, h) + aoff + m * 2048 + k * 1024); } while (0)
#define PG8_LDB(dst, b, h) do { _Pragma("unroll") for (int n = 0; n < 2; ++n) _Pragma("unroll") for (int k = 0; k < 2; ++k) dst[n][k] = *(const PG8_LAS bf16x8*)(lds + PG8_SB(b, h) + boff + n * 2048 + k * 1024); } while (0)
#define PG8_MMA(ai, bj, At, Bt) do { __builtin_amdgcn_s_setprio(1); _Pragma("unroll") for (int m = 0; m < 4; ++m) _Pragma("unroll") for (int n = 0; n < 2; ++n) _Pragma("unroll") for (int k = 0; k < 2; ++k) \
        acc[ai][bj][m][n] = __builtin_amdgcn_mfma_f32_16x16x32_bf16(Bt[n][k], At[m][k], acc[ai][bj][m][n], 0, 0, 0); __builtin_amdgcn_s_setprio(0); } while (0)
#define PG8_WAIT_V(n) asm volatile("s_waitcnt vmcnt(" #n ")" ::: "memory")
#define PG8_WAIT_L(n) asm volatile("s_waitcnt lgkmcnt(" #n ")" ::: "memory")
#define PG8_BAR __builtin_amdgcn_s_barrier()
#define PG8_SCHED __builtin_amdgcn_sched_barrier(0)
    Unit cur, nxt; int ui = 0;
    if (!S.next(0, cur)) return;
    f32x4 acc[2][2][4][2];
#pragma unroll
    for (int a = 0; a < 2; ++a)
#pragma unroll
        for (int b = 0; b < 2; ++b)
#pragma unroll
            for (int m = 0; m < 4; ++m)
#pragma unroll
                for (int n = 0; n < 2; ++n) acc[a][b][m][n] = (f32x4){0.f, 0.f, 0.f, 0.f};
    bf16x8 At[4][2], B0[2][2], B1[2][2];
    const char* cA = (const char*)g.A + (size_t)cur.pm * tstep; const char* cB = (const char*)g.Bt + (size_t)cur.pn * tstep;
    S.a_ready(cur);
    if constexpr (SP2) {
        PG8_STAGE(PG8_SB(0, 0), cB, voffB); PG8_STAGE(PG8_SB(0, 1), cB + hstep, voffB); PG8_STAGE(PG8_SA(0, 0), cA, voffA); PG8_STAGE(PG8_SA(0, 1), cA + hstep, voffA);
        if (wr == 1) PG8_BAR;
        PG8_WAIT_V(2); PG8_BAR;
        PG8_STAGE(PG8_SB(1, 0), cB + kstep, voffB); PG8_STAGE(PG8_SA(1, 0), cA + kstep, voffA); PG8_STAGE(PG8_SB(1, 1), cB + hstep + kstep, voffB);
        PG8_WAIT_V(6); PG8_BAR;
    } else {
        PG8_STAGE(PG8_SB(0, 0), cB, voffB); PG8_STAGE(PG8_SA(0, 0), cA, voffA); PG8_STAGE(PG8_SB(0, 1), cB + hstep, voffB); PG8_STAGE(PG8_SA(0, 1), cA + hstep, voffA);
        if (wr == 1) PG8_BAR;
        PG8_WAIT_V(4); PG8_BAR;
        PG8_STAGE(PG8_SB(1, 0), cB + kstep, voffB); PG8_STAGE(PG8_SA(1, 0), cA + kstep, voffA); PG8_STAGE(PG8_SB(1, 1), cB + hstep + kstep, voffB);
        PG8_WAIT_V(6); PG8_BAR;
    }
    for (;;) {
        const bool has_next = S.next(ui + 1, nxt);
        const char* nA = has_next ? (const char*)g.A + (size_t)nxt.pm * tstep : cA; const char* nB = has_next ? (const char*)g.Bt + (size_t)nxt.pn * tstep : cB;
        for (int t = 0; t < nt; t += 2) {
            const bool last = (t == nt - 2);
            const char* a1 = cA + (size_t)(t + 1) * kstep;
            const char* a2 = last ? nA : cA + (size_t)(t + 2) * kstep; const char* b2 = last ? nB : cB + (size_t)(t + 2) * kstep;
            const char* a3 = a2 + kstep; const char* b3 = b2 + kstep;
            if (last && has_next) S.a_ready(nxt);
            if constexpr (SP2) {
            PG8_LDB(B0, 0, 0); PG8_LDB(B1, 0, 1); PG8_SCHED; PG8_LDA(At, 0, 0); PG8_STAGE(PG8_SA(1, 1), a1 + hstep, voffA);
            PG8_WAIT_V(8); PG8_WAIT_L(0); PG8_BAR; PG8_MMA(0, 0, At, B0); PG8_MMA(0, 1, At, B1); PG8_BAR; PG8_SCHED;
            PG8_LDA(At, 0, 1); PG8_STAGE(PG8_SB(0, 0), b2, voffB); PG8_STAGE(PG8_SB(0, 1), b2 + hstep, voffB); PG8_STAGE(PG8_SA(0, 0), a2, voffA);
            PG8_WAIT_V(8); PG8_WAIT_L(0); PG8_BAR; PG8_MMA(1, 0, At, B0); PG8_MMA(1, 1, At, B1); PG8_BAR; PG8_SCHED;
            PG8_LDB(B0, 1, 0); PG8_LDB(B1, 1, 1); PG8_SCHED; PG8_LDA(At, 1, 0); PG8_STAGE(PG8_SA(0, 1), a2 + hstep, voffA);
            PG8_WAIT_V(8); PG8_WAIT_L(0); PG8_BAR; PG8_MMA(0, 0, At, B0); PG8_MMA(0, 1, At, B1); PG8_BAR; PG8_SCHED;
            PG8_LDA(At, 1, 1); PG8_STAGE(PG8_SB(1, 0), b3, voffB); PG8_STAGE(PG8_SB(1, 1), b3 + hstep, voffB); PG8_STAGE(PG8_SA(1, 0), a3, voffA);
            PG8_WAIT_V(8); PG8_WAIT_L(0); PG8_BAR; PG8_MMA(1, 0, At, B0); PG8_MMA(1, 1, At, B1); PG8_BAR; PG8_SCHED;
            } else {
            PG8_LDB(B0, 0, 0); PG8_SCHED; PG8_LDA(At, 0, 0); PG8_STAGE(PG8_SA(1, 1), a1 + hstep, voffA);
            PG8_WAIT_L(8); PG8_BAR; PG8_WAIT_L(0); PG8_MMA(0, 0, At, B0); PG8_BAR; PG8_SCHED;
            PG8_LDB(B1, 0, 1); PG8_STAGE(PG8_SB(0, 0), b2, voffB);
            PG8_BAR; PG8_WAIT_L(0); PG8_MMA(0, 1, At, B1); PG8_BAR;
            PG8_LDA(At, 0, 1); PG8_STAGE(PG8_SA(0, 0), a2, voffA);
            PG8_BAR; PG8_WAIT_L(0); PG8_MMA(1, 0, At, B0); PG8_BAR; PG8_SCHED;
            PG8_STAGE(PG8_SB(0, 1), b2 + hstep, voffB);
            PG8_WAIT_V(6); PG8_BAR; PG8_MMA(1, 1, At, B1); PG8_BAR;
            PG8_LDB(B0, 1, 0); PG8_SCHED; PG8_LDA(At, 1, 0); PG8_STAGE(PG8_SA(0, 1), a2 + hstep, voffA);
            PG8_WAIT_L(8); PG8_BAR; PG8_WAIT_L(0); PG8_MMA(0, 0, At, B0); PG8_BAR; PG8_SCHED;
            PG8_LDB(B1, 1, 1); PG8_STAGE(PG8_SB(1, 0), b3, voffB);
            PG8_BAR; PG8_WAIT_L(0); PG8_MMA(0, 1, At, B1); PG8_BAR;
            PG8_LDA(At, 1, 1); PG8_STAGE(PG8_SA(1, 0), a3, voffA);
            PG8_BAR; PG8_WAIT_L(0); PG8_MMA(1, 0, At, B0); PG8_BAR; PG8_SCHED;
            PG8_STAGE(PG8_SB(1, 1), b3 + hstep, voffB);
            PG8_WAIT_V(6); PG8_BAR; PG8_MMA(1, 1, At, B1); PG8_BAR;
            }
        }
        if constexpr (ALIGN_EPI) { if (wr == 0) PG8_BAR; }
        if constexpr (!Epi::AFTER_DRAIN) { E(acc, cur, wr, wc, fr, fq); S.done(cur); }
        if (!has_next) break;
#pragma unroll
        for (int a = 0; a < 2; ++a)
#pragma unroll
            for (int b = 0; b < 2; ++b)
#pragma unroll
                for (int m = 0; m < 4; ++m)
#pragma unroll
                    for (int n = 0; n < 2; ++n) acc[a][b][m][n] = (f32x4){0.f, 0.f, 0.f, 0.f};
        cur = nxt; cA = nA; cB = nB; ++ui;
        if constexpr (ALIGN_EPI) { if (wr == 1) PG8_BAR; }
    }
    PG8_WAIT_V(0);
    if constexpr (!ALIGN_EPI) { if (wr == 0) PG8_BAR; }
    PG8_BAR;
    if constexpr (Epi::AFTER_DRAIN) { E.fused(acc, cur, wr, wc, fr, fq, lds, wid, lane); S.done(cur); }
#undef PG8_SA
#undef PG8_SB
#undef PG8_STAGE
#undef PG8_LDA
#undef PG8_LDB
#undef PG8_MMA
#undef PG8_WAIT_V
#undef PG8_WAIT_L
#undef PG8_BAR
#undef PG8_SCHED
}
}

#define LAS __attribute__((address_space(3)))
typedef unsigned short bf16;
typedef float f32x4 __attribute__((ext_vector_type(4)));
typedef unsigned u32x4 __attribute__((ext_vector_type(4)));
typedef unsigned u32x2 __attribute__((ext_vector_type(2)));
constexpr int D = 1024, NB = 16, SEQ = 4096, M = NB * SEQ, CH = 64, NCHUNK = SEQ / CH;
constexpr int DIN = 3740, NP = 3840;
constexpr float LN_EPS = 1e-5f, NORM_EPS = 1e-6f, ALPHA = 1.41421356237f;
constexpr int A_BASE = 0;
constexpr int C_BASE = 1024;
constexpr int B_BASE = 2560;
constexpr int LR_COL = 3712, AC_COL = 3728, BC_COL = 3734;
__host__ __device__ inline int old_col(int n) {
    if (n < 1024) { const int h = n >> 8, r = n & 255, seg = r >> 6, c = r & 63; return seg * 256 + h * 64 + c; }
    if (n < 2560) { const int m = n - 1024, h = m >> 8, r = m & 255, seg = r >> 6, c = r & 63; return seg < 3 ? 2192 + seg * 384 + h * 64 + c : 3356 + h * 64 + c; }
    if (n < 3712) { const int m = n - 2560, h = m / 288, r = m % 288;
        if (r < 48) return 1024 + h * 48 + r; if (r < 96) return 1216 + h * 48 + (r - 48); if (r < 192) return 1408 + h * 96 + (r - 96); return 1808 + h * 96 + (r - 192); }
    if (n < 3728) return 1792 + (n - 3712);
    if (n < 3734) return 3344 + (n - 3728);
    if (n < 3740) return 3350 + (n - 3734);
    return -1;
}
constexpr size_t MiB = 1u << 20;
constexpr size_t WS_CTL = 0, WS_WIN = 1 * MiB, WS_WOUT = 16 * MiB, WS_MOD = 20 * MiB, WS_LB = 21 * MiB;
constexpr size_t WS_HY = 32 * MiB, WS_X1 = 160 * MiB, WS_PROJ = 416 * MiB, WS_END = 896 * MiB;
constexpr int LDS_BYTES = 147456;
constexpr int NTHREADS = 512;

struct Args { const float* in[17]; float* out; unsigned char* ws; int ph_lo, ph_hi; };
enum { I_X = 0, I_C, I_WIN, I_WOUT, I_ADAW, I_ADAB, I_LNG, I_LNB, I_LBL, I_WGK, I_BGK, I_CONV, I_ALOG, I_DTB, I_GA, I_GB, I_GC };

__device__ __forceinline__ unsigned f2bf(float f) { unsigned u = __builtin_bit_cast(unsigned, f); return (u + 0x7fffu + ((u >> 16) & 1u)) >> 16; }
__device__ __forceinline__ unsigned pk2(float lo, float hi) { return f2bf(lo) | (f2bf(hi) << 16); }
__device__ __forceinline__ float bf2f(bf16 b) { return __builtin_bit_cast(float, ((unsigned)b) << 16); }
__device__ __forceinline__ float wave_sum(float v) {
#pragma unroll
    for (int o = 1; o < 64; o <<= 1) v += __shfl_xor(v, o);
    return v;
}
__device__ __forceinline__ float sigmoidf_(float x) { return 1.0f / (1.0f + __expf(-x)); }
__device__ __forceinline__ float siluf_(float x) { return x / (1.0f + __expf(-x)); }
__device__ __forceinline__ float softplusf_(float x) { return x > 20.f ? x : log1pf(__expf(x)); }
__device__ __forceinline__ float logsigmoidf_(float x) { return x < 0.f ? x - log1pf(__expf(x)) : -log1pf(__expf(-x)); }

__device__ __forceinline__ void p0_prep(const Args& a, unsigned char* lds_g) {
    int tid = threadIdx.x; asm volatile("" : "+v"(tid)); const int G = gridDim.x, bid = blockIdx.x;
    unsigned char* ws = a.ws;
    if (bid < 192) {
        float* cact = (float*)lds_g;
        float* part = cact + 16 * 1024;
        const float* c = a.in[I_C];
        for (int i = tid; i < 16 * 1024; i += NTHREADS) cact[i] = siluf_(c[i]);
        __syncthreads();
        const int l = bid / 96, j0 = (bid % 96) * 32, col = tid & 31, ks = tid >> 5;
        const float* W = a.in[I_ADAW] + (size_t)l * 1024 * 3072 + j0 + col;
        float acc[16];
#pragma unroll
        for (int b = 0; b < 16; ++b) acc[b] = 0.f;
        for (int k = ks * 64; k < ks * 64 + 64; ++k) {
            const float w = W[(size_t)k * 3072];
#pragma unroll
            for (int b = 0; b < 16; ++b) acc[b] += cact[b * 1024 + k] * w;
        }
#pragma unroll
        for (int b = 0; b < 16; ++b) part[(ks * 16 + b) * 32 + col] = acc[b];
        __syncthreads();
        { const int b = tid >> 5; float s = 0.f;
#pragma unroll
          for (int k2 = 0; k2 < 16; ++k2) s += part[(k2 * 16 + b) * 32 + col];
          s += a.in[I_ADAB][l * 3072 + j0 + col];
          ((float*)(ws + WS_MOD))[(size_t)(l * 16 + b) * 3072 + j0 + col] = s; }
        __syncthreads();
    }
    if (bid == 255) {
        const int l = tid >> 8, cc = tid & 255;
        const float l0 = a.in[I_LBL][cc], l1 = a.in[I_LBL][256 + cc];
        ((float*)(ws + WS_LB))[tid] = l == 0 ? 0.f : 1.0f / (1.0f + __expf(l0 - l1));
    }
    {
        const size_t gt = (size_t)bid * NTHREADS + tid, GT = (size_t)G * NTHREADS;
        bf16* WinT = (bf16*)(ws + WS_WIN);
        for (size_t idx = gt; idx < (size_t)2 * 128 * NP; idx += GT) {
            const int n = (int)(idx % NP), kb = (int)((idx / NP) % 128), l = (int)(idx / ((size_t)NP * 128));
            const int oc = old_col(n);
            float v[8];
#pragma unroll
            for (int j = 0; j < 8; ++j) v[j] = oc >= 0 ? a.in[I_WIN][((size_t)l * 1024 + kb * 8 + j) * DIN + oc] : 0.f;
            u32x4 o; o.x = pk2(v[0], v[1]); o.y = pk2(v[2], v[3]); o.z = pk2(v[4], v[5]); o.w = pk2(v[6], v[7]);
            *(u32x4*)(WinT + ((size_t)l * NP + n) * 1024 + kb * 8) = o;
        }
        bf16* WoutT = (bf16*)(ws + WS_WOUT);
        for (size_t idx = gt; idx < (size_t)2 * 128 * 1024; idx += GT) {
            const int n = (int)(idx % 1024), kb = (int)((idx / 1024) % 128), l = (int)(idx / ((size_t)1024 * 128));
            float v[8];
#pragma unroll
            for (int j = 0; j < 8; ++j) v[j] = a.in[I_WOUT][((size_t)l * 1024 + kb * 8 + j) * 1024 + n];
            u32x4 o; o.x = pk2(v[0], v[1]); o.y = pk2(v[2], v[3]); o.z = pk2(v[4], v[5]); o.w = pk2(v[6], v[7]);
            *(u32x4*)(WoutT + ((size_t)l * 1024 + n) * 1024 + kb * 8) = o;
        }
    }
}

template <int MODE>
__device__ __forceinline__ void ln_rows(const float* src, float* xo, bf16* hout, const float* lng, const float* lnb, const float* mod  ) {
    int tid = threadIdx.x; asm volatile("" : "+v"(tid));
    const int lane = tid & 63, wave = tid >> 6;
    const int gw = blockIdx.x * 8 + wave, NGW = gridDim.x * 8;
    for (int m = gw; m < M; m += NGW) {
        const f32x4* xr = (const f32x4*)(src + (size_t)m * D) + lane;
        f32x4 v[4]; float s = 0.f;
#pragma unroll
        for (int j = 0; j < 4; ++j) { v[j] = xr[64 * j]; s += (v[j].x + v[j].y) + (v[j].z + v[j].w); }
        float mean = wave_sum(s) * (1.f / D); float s2 = 0.f;
#pragma unroll
        for (int j = 0; j < 4; ++j) { v[j] = v[j] - mean; s2 += (v[j].x * v[j].x + v[j].y * v[j].y) + (v[j].z * v[j].z + v[j].w * v[j].w); }
        float rstd = 1.f / sqrtf(wave_sum(s2) * (1.f / D) + LN_EPS);
        const int b = m >> 12;
        if (MODE == 1) {
            s = 0.f;
#pragma unroll
            for (int j = 0; j < 4; ++j) { const f32x4 g = *((const f32x4*)lng + lane + 64 * j), bb = *((const f32x4*)lnb + lane + 64 * j);
                v[j] = v[j] * rstd * g + bb; *((f32x4*)(xo + (size_t)m * D) + lane + 64 * j) = v[j]; s += (v[j].x + v[j].y) + (v[j].z + v[j].w); }
            if (!hout) continue;
            mean = wave_sum(s) * (1.f / D); s2 = 0.f;
#pragma unroll
            for (int j = 0; j < 4; ++j) { v[j] = v[j] - mean; s2 += (v[j].x * v[j].x + v[j].y * v[j].y) + (v[j].z * v[j].z + v[j].w * v[j].w); }
            rstd = 1.f / sqrtf(wave_sum(s2) * (1.f / D) + LN_EPS);
        }
        const float* mb = mod + (size_t)b * 3072;
#pragma unroll
        for (int j = 0; j < 4; ++j) { const f32x4 sh = *((const f32x4*)mb + lane + 64 * j), sc = *((const f32x4*)(mb + 1024) + lane + 64 * j);
            const f32x4 h = v[j] * rstd * (sc + 1.0f) + sh;
            u32x2 w; w.x = pk2(h.x, h.y); w.y = pk2(h.z, h.w);
            *((u32x2*)(hout + (size_t)m * D) + lane + 64 * j) = w; }
    }
}

struct EpiRes {
    static constexpr bool PERM = false, AFTER_DRAIN = false;
    const float* xin; float* res; const float* gate;
    __device__ __forceinline__ void operator()(const pg8::f32x4 (&acc)[2][2][4][2], const pg8::Unit& u, int wr, int wc, int fr, int fq) const {
        const int row0 = u.pm * 256 + wr * 64 + fr, col0 = u.pn * 256 + wc * 32 + 4 * fq;
#pragma unroll
        for (int ai = 0; ai < 2; ++ai)
#pragma unroll
            for (int m = 0; m < 4; ++m) { const int row = row0 + ai * 128 + m * 16; const int b = row >> 12;
#pragma unroll
                for (int bj = 0; bj < 2; ++bj)
#pragma unroll
                    for (int n = 0; n < 2; ++n) { const int col = col0 + bj * 128 + n * 16;
                        const f32x4 g = *(const f32x4*)(gate + (size_t)b * 3072 + col), xv = *(const f32x4*)(xin + (size_t)row * D + col);
                        *(f32x4*)(res + (size_t)row * D + col) = xv * ALPHA + g * acc[ai][bj][m][n]; } }
    }
};

template <int DK, int DV, bool ISA>
__device__ __forceinline__ void mix_gla_base(const Args& a, int layer, int b, int h, float* lds) {
    constexpr int PK = DK + 1, PV = DV + 1;
    float* q = lds; float* k = q + 64 * PK; float* bc = k + 64 * PK; float* v = bc + 64 * PK; float* sc = v + 64 * PV; float* S = sc + 64 * 65; float* o = S + DK * DV; float* rinv = o + 64 * PV;
    int tid0 = threadIdx.x; asm volatile("" : "+v"(tid0));
    const bf16* proj = (const bf16*)(a.ws + WS_PROJ);
    bf16* y = (bf16*)(a.ws + WS_HY);
    const int base = ISA ? A_BASE + 256 * h : B_BASE + 288 * h;
    const int vcol = ISA ? base + 128 : base + 96, zcol = ISA ? base + 192 : base + 192;
    const int ycol = ISA ? 64 * h : 256 + 96 * h;
    const float* gain = ISA ? a.in[I_GA] + layer * 64 : a.in[I_GB] + layer * 96;
    const float* lb = (const float*)(a.ws + WS_LB) + layer * 256 + h * 64;
    const float* wgk = a.in[I_WGK] + (size_t)layer * 16 * 192 + h * 48;
    const float* bgk = a.in[I_BGK] + layer * 192 + h * 48;
    for (int i = tid0; i < DK * DV; i += NTHREADS) S[i] = 0.f;
    for (int n = 0; n < NCHUNK; ++n) {
        int tid = tid0; asm volatile("" : "+v"(tid));
        const size_t t0 = (size_t)b * SEQ + (size_t)n * 64;
        __syncthreads();
        for (int i = tid; i < 64 * DK; i += NTHREADS) { const int t = i / DK, c = i % DK; const bf16* row = proj + (t0 + t) * NP;
            if (ISA) { const float qr = bf2f(row[base + c]), fl = bf2f(row[base + 64 + c]); const float sg = sigmoidf_(fl), lbv = lb[c];
                q[t * PK + c] = siluf_(qr); const float f = lbv + (1.f - lbv) * sg; bc[t * PK + c] = __logf(fmaxf(f, 1e-30f)); k[t * PK + c] = (1.f - lbv) * sigmoidf_(-fl); }
            else { q[t * PK + c] = bf2f(row[base + c]) * 0.14433756729740643f; k[t * PK + c] = bf2f(row[base + 48 + c]);
                float s = bgk[c];
#pragma unroll
                for (int r = 0; r < 16; ++r) s += bf2f(row[LR_COL + r]) * wgk[r * 192 + c];
                bc[t * PK + c] = logsigmoidf_(s) * (1.0f / 16.0f); } }
        for (int i = tid; i < 64 * DV; i += NTHREADS) { const int t = i / DV, c = i % DV; v[t * PV + c] = bf2f(proj[(t0 + t) * NP + vcol + c]); }
        __syncthreads();
        if (tid < DK) { float run = 0.f; for (int t = 0; t < 64; ++t) { run += bc[t * PK + tid]; bc[t * PK + tid] = run; } }
        __syncthreads();
        for (int i = tid; i < 64 * 64; i += NTHREADS) { const int t = i >> 6, s = i & 63; float acc = 0.f;
            if (s <= t) for (int c = 0; c < DK; ++c) acc += q[t * PK + c] * k[s * PK + c] * __expf(bc[t * PK + c] - bc[s * PK + c]);
            sc[t * 65 + s] = acc; }
        __syncthreads();
        for (int i = tid; i < 64 * DV; i += NTHREADS) { const int t = i / DV, c = i % DV; float acc = 0.f;
            for (int s = 0; s <= t; ++s) acc += sc[t * 65 + s] * v[s * PV + c];
            for (int kk = 0; kk < DK; ++kk) acc += q[t * PK + kk] * __expf(bc[t * PK + kk]) * S[kk * DV + c];
            o[t * PV + c] = acc; }
        __syncthreads();
        for (int i = tid; i < DK * DV; i += NTHREADS) { const int kk = i / DV, c = i % DV; const float bl = bc[63 * PK + kk]; float acc = __expf(bl) * S[i];
            for (int s = 0; s < 64; ++s) acc += k[s * PK + kk] * __expf(bl - bc[s * PK + kk]) * v[s * PV + c];
            S[i] = acc; }
        if (tid < 64) { float s2 = 0.f; for (int c = 0; c < DV; ++c) s2 += o[tid * PV + c] * o[tid * PV + c]; rinv[tid] = 1.0f / sqrtf(s2 * (1.0f / DV) + NORM_EPS); }
        __syncthreads();
        for (int i = tid; i < 64 * DV; i += NTHREADS) { const int t = i / DV, c = i % DV; const float z = bf2f(proj[(t0 + t) * NP + zcol + c]);
            y[(t0 + t) * D + ycol + c] = (bf16)f2bf(o[t * PV + c] * rinv[t] * gain[c] * siluf_(z)); }
    }
}
__device__ __forceinline__ void mix_gdn_base(const Args& a, int layer, int b, int h, float* lds) {
    constexpr int P = 65;
    float* q = lds; float* k = q + 64 * P; float* v = k + 64 * P; float* L = v + 64 * P; float* at = L + 64 * P; float* U = at + 64 * P; float* W = U + 64 * P; float* S = W + 64 * P;
    float* bc = S + 64 * 64; float* beta = bc + 64; float* g = beta + 64; float* rinv = g + 64;
    int tid0 = threadIdx.x; asm volatile("" : "+v"(tid0));
    const bf16* proj = (const bf16*)(a.ws + WS_PROJ);
    bf16* y = (bf16*)(a.ws + WS_HY);
    const int base = C_BASE + 256 * h, ycol = 640 + 64 * h;
    const float* gain = a.in[I_GC] + layer * 64;
    const float* cw = a.in[I_CONV] + (size_t)layer * 4 * 1152;
    const float alog = a.in[I_ALOG][layer * 6 + h], dtb = a.in[I_DTB][layer * 6 + h];
    for (int i = tid0; i < 64 * 64; i += NTHREADS) S[i] = 0.f;
    for (int n = 0; n < NCHUNK; ++n) {
        int tid = tid0; asm volatile("" : "+v"(tid));
        const size_t t0 = (size_t)b * SEQ + (size_t)n * 64;
        __syncthreads();
        for (int i = tid; i < 64 * 192; i += NTHREADS) { const int t = i / 192, cc = i % 192, seg = cc >> 6, c = cc & 63; const int ch = seg * 384 + h * 64 + c; float acc = 0.f;
#pragma unroll
            for (int j = 0; j < 4; ++j) { const int p = n * 64 + t - 3 + j; if (p >= 0) acc += cw[j * 1152 + ch] * bf2f(proj[((size_t)b * SEQ + p) * NP + base + seg * 64 + c]); }
            const float r = siluf_(acc); (seg == 0 ? q : seg == 1 ? k : v)[t * P + c] = r; }
        if (tid < 64) { const bf16* row = proj + (t0 + tid) * NP; const float av = bf2f(row[AC_COL + h]), bv = bf2f(row[BC_COL + h]);
            g[tid] = -__expf(alog) * softplusf_(av + dtb); beta[tid] = sigmoidf_(bv); }
        __syncthreads();
        if (tid < 64) { float sq = 0.f, sk = 0.f; for (int c = 0; c < 64; ++c) { sq += q[tid * P + c] * q[tid * P + c]; sk += k[tid * P + c] * k[tid * P + c]; }
            const float nq = 0.125f / sqrtf(sq + NORM_EPS), nk = 1.0f / sqrtf(sk + NORM_EPS);
            for (int c = 0; c < 64; ++c) { q[tid * P + c] *= nq; k[tid * P + c] *= nk; } }
        if (tid == 64) { float run = 0.f; for (int t = 0; t < 64; ++t) { run += g[t]; bc[t] = run; } }
        __syncthreads();
        for (int i = tid; i < 64 * 64; i += NTHREADS) { const int t = i >> 6, s = i & 63; float kk = 0.f, qk = 0.f;
            if (s <= t) { for (int c = 0; c < 64; ++c) { kk += k[t * P + c] * k[s * P + c]; qk += q[t * P + c] * k[s * P + c]; } }
            const float dec = s <= t ? __expf(bc[t] - bc[s]) : 0.f;
            L[t * P + s] = s < t ? beta[t] * kk * dec : 0.f; at[t * P + s] = qk * dec;
            U[t * P + s] = v[t * P + s] * beta[t]; W[t * P + s] = k[t * P + s] * beta[t] * __expf(bc[t]); }
        __syncthreads();
        if (tid < 128) { float* X = (tid < 64 ? U : W); const int c = tid & 63;
            for (int t = 1; t < 64; ++t) { float acc = X[t * P + c]; for (int s = 0; s < t; ++s) acc -= L[t * P + s] * X[s * P + c]; X[t * P + c] = acc; } }
        __syncthreads();
        for (int i = tid; i < 64 * 64; i += NTHREADS) { const int t = i >> 6, c = i & 63; float acc = U[t * P + c];
            for (int kk = 0; kk < 64; ++kk) acc -= W[t * P + kk] * S[kk * 64 + c];
            U[t * P + c] = acc; }
        __syncthreads();
        for (int i = tid; i < 64 * 64; i += NTHREADS) { const int t = i >> 6, c = i & 63; float acc = 0.f; const float eb = __expf(bc[t]);
            for (int kk = 0; kk < 64; ++kk) acc += q[t * P + kk] * eb * S[kk * 64 + c];
            for (int s = 0; s <= t; ++s) acc += at[t * P + s] * U[s * P + c];
            L[t * P + c] = acc; }
        __syncthreads();
        for (int i = tid; i < 64 * 64; i += NTHREADS) { const int kk = i >> 6, c = i & 63; const float bl = bc[63]; float acc = __expf(bl) * S[i];
            for (int s = 0; s < 64; ++s) acc += k[s * P + kk] * __expf(bl - bc[s]) * U[s * P + c];
            S[i] = acc; }
        if (tid < 64) { float s2 = 0.f; for (int c = 0; c < 64; ++c) s2 += L[tid * P + c] * L[tid * P + c]; rinv[tid] = 1.0f / sqrtf(s2 * (1.0f / 64) + NORM_EPS); }
        __syncthreads();
        for (int i = tid; i < 64 * 64; i += NTHREADS) { const int t = i >> 6, c = i & 63; const float z = bf2f(proj[(t0 + t) * NP + base + 192 + c]);
            y[(t0 + t) * D + ycol + c] = (bf16)f2bf(L[t * P + c] * rinv[t] * gain[c] * siluf_(z)); }
    }
}
__device__ __forceinline__ void p3_mixers_base(const Args& a, int layer, unsigned char* lds_g) {
    const int id = blockIdx.x;
    if (id < 96) mix_gdn_base(a, layer, id / 6, id % 6, (float*)lds_g);
    else if (id < 160) mix_gla_base<64, 64, true>(a, layer, (id - 96) >> 2, (id - 96) & 3, (float*)lds_g);
    else if (id < 224) mix_gla_base<48, 96, false>(a, layer, (id - 160) >> 2, (id - 160) & 3, (float*)lds_g);
}

#ifndef MK_ONE_LAUNCH
#define MK_ONE_LAUNCH 0
#endif
constexpr int N_PHASES = 10;
template <int PLO, int PHI> __global__ void __launch_bounds__(NTHREADS, 2) mega(Args args_) {
    extern __shared__ __attribute__((aligned(16))) unsigned char lds[];
#if defined(__HIP_DEVICE_COMPILE__)
#define ARGS() const Args args = *({ const __attribute__((address_space(4))) Args* ap_ = (const __attribute__((address_space(4))) Args*)__builtin_amdgcn_kernarg_segment_ptr(); asm volatile("" : "+s"(ap_)); ap_; })
#else
#define ARGS() const Args args = args_
#endif
    constexpr int lo = PLO, hi = PHI;
#define IN(k) (lo <= (k) && (k) < hi)
#define SEAM(k) do { if (IN(k) && IN((k) + 1)) { cg::this_grid().sync(); } } while (0)
#define WSP(T, off) ((T*)(args.ws + (off)))
    if (IN(0)) { ARGS(); p0_prep(args, lds); }
    SEAM(0);
    if (IN(1)) { ARGS(); ln_rows<0>(args.in[I_X], nullptr, WSP(bf16, WS_HY), nullptr, nullptr, WSP(float, WS_MOD)); }
    SEAM(1);
#pragma unroll
    for (int l = 0; l < 2; ++l) {
        const int p = 2 + 4 * l;
        if (IN(p)) { ARGS();
            pg8::Gemm g{WSP(bf16, WS_HY), WSP(bf16, WS_WIN) + (size_t)l * NP * 1024, M, NP, D}; pg8::StaticOrder S; S.init(M, NP, gridDim.x, (int)blockIdx.x);
            pg8::EpiBf16<0> E{WSP(bf16, WS_PROJ), NP, nullptr, 0, 0, 1.f};
            pg8::gemm_phase<pg8::EpiBf16<0>, pg8::StaticOrder, true, true>((PG8_LAS unsigned char*)lds, g, S, E);
        }
        SEAM(p);
        if (IN(p + 1)) { ARGS(); p3_mixers_base(args, l, lds); }
        SEAM(p + 1);
        if (IN(p + 2)) { ARGS();
            const float* xin = l == 0 ? args.in[I_X] : WSP(float, WS_X1);
            pg8::Gemm g{WSP(bf16, WS_HY), WSP(bf16, WS_WOUT) + (size_t)l * 1024 * 1024, M, D, D}; pg8::StaticOrder S; S.init(M, D, gridDim.x, (int)blockIdx.x);
            EpiRes E{xin, args.out, WSP(float, WS_MOD) + (size_t)l * 16 * 3072 + 2048};
            pg8::gemm_phase<EpiRes, pg8::StaticOrder, true, true>((PG8_LAS unsigned char*)lds, g, S, E);
        }
        SEAM(p + 2);
        if (IN(p + 3)) { ARGS();
            if (l == 0) ln_rows<1>(args.out, WSP(float, WS_X1), WSP(bf16, WS_HY), args.in[I_LNG], args.in[I_LNB], WSP(float, WS_MOD) + (size_t)16 * 3072);
            else ln_rows<1>(args.out, args.out, nullptr, args.in[I_LNG] + 1024, args.in[I_LNB] + 1024, nullptr);
        }
        if (l == 0) SEAM(p + 3);
    }
#undef WSP
#undef ARGS
#undef IN
#undef SEAM
}

#include <utility>
template <int P> static hipError_t set_attr1() { return hipFuncSetAttribute((const void*)mega<P, P + 1>, hipFuncAttributeMaxDynamicSharedMemorySize, LDS_BYTES); }
template <int... P> static hipError_t set_attrs_(std::integer_sequence<int, P...>) { hipError_t e = hipSuccess; hipError_t r[] = {set_attr1<P>()...}; for (hipError_t x : r) if (x != hipSuccess) e = x; return e; }
static hipError_t set_attrs() {
#if MK_ONE_LAUNCH
    return hipFuncSetAttribute((const void*)mega<0, N_PHASES>, hipFuncAttributeMaxDynamicSharedMemorySize, LDS_BYTES);
#else
    return set_attrs_(std::make_integer_sequence<int, N_PHASES>{});
#endif
}
template <int P> static int launch1(const Args& a, int grid, hipStream_t stream) { hipLaunchKernelGGL((mega<P, P + 1>), dim3(grid), dim3(NTHREADS), LDS_BYTES, stream, a); return 0; }
template <int... P> static void launch_all(const Args& a, int grid, hipStream_t stream, std::integer_sequence<int, P...>) { int r[] = {launch1<P>(a, grid, stream)...}; (void)r; }
extern "C" void kernel_launch(void* const* d_in, const int* in_sizes, int n_in, void* d_out, int out_size, void* d_ws, size_t ws_size, hipStream_t stream) {
    static int grid = 0;
    if (grid == 0) {
        if (n_in != 17 || out_size != M * D || ws_size < WS_END) { fprintf(stderr, "kernel_launch: unexpected shapes (n_in %d out %d ws %zu)\n", n_in, out_size, ws_size); grid = -1; return; }
        if (set_attrs() != hipSuccess) { fprintf(stderr, "kernel_launch: hipFuncSetAttribute failed\n"); grid = -1; return; }
        int dev = 0, cus = 0, per_cu = 0;
        (void)hipGetDevice(&dev); (void)hipDeviceGetAttribute(&cus, hipDeviceAttributeMultiprocessorCount, dev);
#if MK_ONE_LAUNCH
        (void)hipOccupancyMaxActiveBlocksPerMultiprocessor(&per_cu, (const void*)mega<0, N_PHASES>, NTHREADS, LDS_BYTES);
#else
        per_cu = 1;
#endif
        if (per_cu < 1 || cus < 256) { fprintf(stderr, "kernel_launch: occupancy %d blocks/CU, %d CUs: cannot run\n", per_cu, cus); grid = -1; return; }
        grid = 256;
    }
    if (grid < 0) return;
    Args a{};
    for (int i = 0; i < 17; ++i) a.in[i] = (const float*)d_in[i];
    a.out = (float*)d_out; a.ws = (unsigned char*)d_ws;
#if MK_ONE_LAUNCH
    a.ph_lo = 0; a.ph_hi = N_PHASES;
    void* kargs[] = {&a};
    hipError_t e = hipLaunchCooperativeKernel((const void*)mega<0, N_PHASES>, dim3(grid), dim3(NTHREADS), kargs, LDS_BYTES, stream);
    if (e != hipSuccess) fprintf(stderr, "kernel_launch: cooperative launch failed: %s\n", hipGetErrorString(e));
#else
    launch_all(a, grid, stream, std::make_integer_sequence<int, N_PHASES>{});
#endif
}
```

```cpp
#include <hip/hip_runtime.h>
#include <hip/hip_cooperative_groups.h>
#include <cstdio>
#include <cstdint>
namespace cg = cooperative_groups;
#define MK_ONE_LAUNCH 1
#define FAST_C 1
#define FAST_A 1
#define FAST_B 1
namespace pg8 {
#define PG8_LAS __attribute__((address_space(3)))
typedef unsigned short bf16_t;
typedef short bf16x8 __attribute__((ext_vector_type(8)));
typedef _Float16 half8 __attribute__((ext_vector_type(8)));
typedef float f32x4 __attribute__((ext_vector_type(4)));
typedef unsigned u32x4 __attribute__((ext_vector_type(4)));
constexpr int BM = 256, BK = 64, HALF = 128, HTB = HALF * BK * 2  , STAGE_BYTES = 8 * HTB, NXCD = 8, WGM = 8;

__host__ __device__ __forceinline__ int lds_byte(int r, int c) { const int st = (r >> 4) * 2 + (c >> 5), rr = r & 15, cc = c & 31, ob = rr * 64 + cc * 2; return st * 1024 + (ob ^ (((ob >> 9) & 1) << 5)); }
__host__ __device__ __forceinline__ void stage_rc(int b, int& R, int& C) { const int st = b / 1024, sb = b % 1024, swz = sb ^ (((sb >> 9) & 1) << 5); R = (st >> 1) * 16 + swz / 64; C = (st & 1) * 32 + (swz % 64) / 2; }
__host__ __device__ __forceinline__ int perm32(int rho) { const int n = rho >> 4, i = rho & 15; return 8 * (i >> 2) + 4 * n + (i & 3); }

struct Unit { int pm, pn; };
struct Gemm { const bf16_t* A; const bf16_t* Bt; int M, N, K; };

struct StaticOrder {
    int nM, nN, nwg, G, c;
    __host__ __device__ void init(int M, int N, int G_, int c_) { nM = M / BM; nN = N / BM; nwg = nM * nN; G = G_; c = c_; }
    __host__ __device__ bool next(int i, Unit& u) const {
        const long L = (long)i * G + c; if (L >= nwg) return false;
        int wgid = (int)L; { const int q = nwg / NXCD, r = nwg % NXCD, xcd = wgid % NXCD, off = wgid / NXCD; wgid = (xcd < r ? xcd * (q + 1) : r * (q + 1) + (xcd - r) * q) + off; }
        const int nig = WGM * nN, gid = wgid / nig, fm = gid * WGM, gsz = (nM - fm) < WGM ? (nM - fm) : WGM;
        u.pm = fm + ((wgid % nig) % gsz); u.pn = (wgid % nig) / gsz; return true;
    }
    __device__ __forceinline__ void a_ready(const Unit&) const {}
    __device__ __forceinline__ void done(const Unit&) const {}
};

__device__ __forceinline__ unsigned cvt_pk_bf16(float lo, float hi) { unsigned r; asm volatile("v_cvt_pk_f16_f32 %0, %1, %2" : "=v"(r) : "v"(lo), "v"(hi)); return r; }
typedef float f32x2 __attribute__((ext_vector_type(2)));
__device__ __forceinline__ f32x2 gelu_pk(f32x2 v) {
    const f32x2 av = __builtin_elementwise_abs(v), d = av * 0.2316418882f + 1.0f;
    f32x2 t; t.x = __builtin_amdgcn_rcpf(d.x); t.y = __builtin_amdgcn_rcpf(d.y);
    f32x2 q = t * 0.5307027145f + (-0.7265760135f); q = q * t + 0.7107068705f; q = q * t + (-0.142248368f); q = q * t + 0.127414796f; q = q * t;
    const f32x2 s = (v * v) * (-0.72134752044f);
    f32x2 e; e.x = __builtin_amdgcn_exp2f(s.x); e.y = __builtin_amdgcn_exp2f(s.y);
    const f32x2 m = v * (q * e), r = v - m;
    f32x2 o; o.x = v.x < 0.f ? m.x : r.x; o.y = v.y < 0.f ? m.y : r.y; return o;
}

template <int ACT  > struct EpiBf16 {
    static constexpr bool PERM = true, AFTER_DRAIN = false; static_assert(ACT == 0 || ACT == 1, "EpiBf16: ACT is 0 (none) or 1 (gelu_pk)");
    bf16_t* O; int ldc; const float* bias; int split_cols; size_t split_stride; float scale0;
    __device__ __forceinline__ void operator()(const f32x4 (&acc)[2][2][4][2], const Unit& u, int wr, int wc, int fr, int fq) const {
        const int row0 = u.pm * BM + wr * 64 + fr; int colt = u.pn * BM; bf16_t* base = O;
        float sc = 1.f; if (split_cols) { const int t = colt / split_cols; base += (size_t)t * split_stride; colt -= t * split_cols; if (t == 0) sc = scale0; }
        const int col0 = colt + wc * 32 + 8 * fq, bcol0 = u.pn * BM + wc * 32 + 8 * fq;
        f32x4 bv[2][2];
#pragma unroll
        for (int bj = 0; bj < 2; ++bj)
#pragma unroll
            for (int n = 0; n < 2; ++n) bv[bj][n] = bias ? *(const f32x4*)(bias + bcol0 + bj * HALF + 4 * n) : (f32x4){0.f, 0.f, 0.f, 0.f};
#pragma unroll
        for (int ai = 0; ai < 2; ++ai)
#pragma unroll
            for (int m = 0; m < 4; ++m) { bf16_t* rowp = base + (size_t)(row0 + ai * HALF + m * 16) * ldc + col0;
#pragma unroll
                for (int bj = 0; bj < 2; ++bj) { f32x4 v0 = acc[ai][bj][m][0] + bv[bj][0], v1 = acc[ai][bj][m][1] + bv[bj][1];
                    if (ACT == 1) { f32x2 a = gelu_pk((f32x2){v0[0], v0[1]}), b = gelu_pk((f32x2){v0[2], v0[3]}), c = gelu_pk((f32x2){v1[0], v1[1]}), d = gelu_pk((f32x2){v1[2], v1[3]});
                        v0 = (f32x4){a.x, a.y, b.x, b.y}; v1 = (f32x4){c.x, c.y, d.x, d.y}; }
                    v0 = v0 * sc; v1 = v1 * sc; u32x4 w; w.x = cvt_pk_bf16(v0[0], v0[1]); w.y = cvt_pk_bf16(v0[2], v0[3]); w.z = cvt_pk_bf16(v1[0], v1[1]); w.w = cvt_pk_bf16(v1[2], v1[3]);
                    *(u32x4*)(rowp + bj * HALF) = w; } }
    }
};

struct PanelStats {
    unsigned* xbuf;
    unsigned* cnt;
    unsigned* tmo;
    int ntn; float eps;
    unsigned code;
    __device__ __forceinline__ bool run(const f32x4 (&v)[2][2][4][2], const Unit& u, int wr, int wc, int fr, int fq, PG8_LAS unsigned char* lds, int wid, int lane) const {
        typedef float f32x2v __attribute__((ext_vector_type(2)));
        PG8_LAS f32x2v* P = (PG8_LAS f32x2v*)lds;
        PG8_LAS f32x2v* S = (PG8_LAS f32x2v*)(lds + 8192);
        PG8_LAS unsigned* flag = (PG8_LAS unsigned*)(lds + 8192 + 2048);
#pragma unroll
        for (int ai = 0; ai < 2; ++ai)
#pragma unroll
            for (int m = 0; m < 4; ++m) {
                float s = 0.f;
#pragma unroll
                for (int bj = 0; bj < 2; ++bj)
#pragma unroll
                    for (int n = 0; n < 2; ++n) { const f32x4 x = v[ai][bj][m][n]; s += (x[0] + x[1]) + (x[2] + x[3]); }
                s += __shfl_xor(s, 16); s += __shfl_xor(s, 32);
                const float mw = s * (1.0f / 64.0f); float q = 0.f;
#pragma unroll
                for (int bj = 0; bj < 2; ++bj)
#pragma unroll
                    for (int n = 0; n < 2; ++n) { const f32x4 d = v[ai][bj][m][n] - mw; q += (d[0] * d[0] + d[1] * d[1]) + (d[2] * d[2] + d[3] * d[3]); }
                q += __shfl_xor(q, 16); q += __shfl_xor(q, 32);
                if (fq == 0) P[(ai * HALF + wr * 64 + m * 16 + fr) * 4 + wc] = (f32x2v){mw, q};
            }
        asm volatile("s_waitcnt lgkmcnt(0)" ::: "memory"); __builtin_amdgcn_s_barrier(); asm volatile("" ::: "memory");
#if defined(BROKEN_EXCHANGE_NO_WAIT)
#warning BROKEN CONTROL BUILD: the row-statistics exchange does not wait; results are wrong by design
        if (blockIdx.x >= 64) { const long long t0_ = clock64(); while (clock64() - t0_ < 60000) __builtin_amdgcn_s_sleep(8); }
#endif
        const int row = wid * 32 + (lane & 31);
        if (lane < 32) {
            const f32x2v a = P[row * 4 + 0], b = P[row * 4 + 1], c = P[row * 4 + 2], d = P[row * 4 + 3];
            const float mt = (a.x + b.x + c.x + d.x) * 0.25f;
            const float da = a.x - mt, db = b.x - mt, dc = c.x - mt, dd = d.x - mt;
            const float m2 = (a.y + b.y) + (c.y + d.y) + 64.0f * ((da * da + db * db) + (dc * dc + dd * dd));
            unsigned long long* slot = (unsigned long long*)xbuf + ((size_t)(u.pm * BM + row) * 4 + u.pn);
            __hip_atomic_store(slot, ((unsigned long long)__float_as_uint(m2) << 32) | __float_as_uint(mt), __ATOMIC_RELAXED, __HIP_MEMORY_SCOPE_AGENT);
        }
        asm volatile("s_waitcnt vmcnt(0)" ::: "memory");
        if (lane == 0) __hip_atomic_fetch_add(cnt + 64 * u.pm, 1u, __ATOMIC_RELAXED, __HIP_MEMORY_SCOPE_AGENT);
        if (wid == 0) {
            bool dead = false; const unsigned long long t0 = __builtin_amdgcn_s_memrealtime(); const unsigned want = 8u * (unsigned)ntn;
            for (;;) {
#if defined(BROKEN_EXCHANGE_NO_WAIT)
                break;
#endif
                if ((unsigned)__builtin_amdgcn_readfirstlane(__hip_atomic_load(cnt + 64 * u.pm, __ATOMIC_RELAXED, __HIP_MEMORY_SCOPE_AGENT)) >= want) break;
                if (__builtin_amdgcn_s_memrealtime() - t0 > 2000000ull) {
                    if (lane == 0) { unsigned expect = 0u; __hip_atomic_compare_exchange_strong(tmo + 1, &expect, code | (unsigned)(u.pm & 0xff), __ATOMIC_RELAXED, __ATOMIC_RELAXED, __HIP_MEMORY_SCOPE_AGENT);
                                     __hip_atomic_store(tmo, 1u, __ATOMIC_RELAXED, __HIP_MEMORY_SCOPE_AGENT); }
                    dead = true; break; }
                __builtin_amdgcn_s_sleep(2);
            }
            __builtin_amdgcn_fence(__ATOMIC_ACQUIRE, "agent");
            if (lane == 0) flag[0] = dead ? 1u : 0u;
        }
        asm volatile("s_waitcnt vmcnt(0) lgkmcnt(0)" ::: "memory"); __builtin_amdgcn_s_barrier(); asm volatile("" ::: "memory");
        const bool bad = flag[0] != 0u;
        if (lane < 32) {
            const unsigned long long* slot = (const unsigned long long*)xbuf + (size_t)(u.pm * BM + row) * 4; float mt[4], m2[4]; float ms = 0.f;
#pragma unroll
            for (int t = 0; t < 4; ++t) { if (t < ntn) { const unsigned long long w = __hip_atomic_load(slot + t, __ATOMIC_RELAXED, __HIP_MEMORY_SCOPE_AGENT); mt[t] = __uint_as_float((unsigned)w); m2[t] = __uint_as_float((unsigned)(w >> 32)); } else { mt[t] = 0.f; m2[t] = 0.f; } ms += mt[t]; }
            const float mean = ms / (float)ntn; float q = 0.f;
#pragma unroll
            for (int t = 0; t < 4; ++t) if (t < ntn) { const float dm = mt[t] - mean; q += m2[t] + 256.0f * dm * dm; }
            S[row] = (f32x2v){mean, 1.0f / sqrtf(q / (256.0f * (float)ntn) + eps)};
        }
        asm volatile("s_waitcnt lgkmcnt(0)" ::: "memory"); __builtin_amdgcn_s_barrier(); asm volatile("" ::: "memory");
        return bad;
    }
};
struct EpiLnRes {
    static constexpr bool PERM = false, AFTER_DRAIN = true;
    const float* base; float* out; int ldc; const float* bias; PanelStats st; unsigned poison;
    __device__ __forceinline__ void fused(f32x4 (&acc)[2][2][4][2], const Unit& u, int wr, int wc, int fr, int fq, PG8_LAS unsigned char* lds, int wid, int lane) const {
        typedef float f32x2v __attribute__((ext_vector_type(2)));
        const PG8_LAS f32x2v* S = (const PG8_LAS f32x2v*)(lds + 8192);
        const int col0 = u.pn * BM + wc * 32 + 4 * fq;
#pragma unroll
        for (int bj = 0; bj < 2; ++bj)
#pragma unroll
            for (int n = 0; n < 2; ++n) { const f32x4 bv = bias ? *(const f32x4*)(bias + col0 + bj * HALF + n * 16) : (f32x4){0.f, 0.f, 0.f, 0.f};
#pragma unroll
                for (int ai = 0; ai < 2; ++ai)
#pragma unroll
                    for (int m = 0; m < 4; ++m) acc[ai][bj][m][n] += bv; }
        f32x4 pre[4][2][2];
#pragma unroll
        for (int m = 0; m < 4; ++m) { const size_t off = (size_t)(u.pm * BM + wr * 64 + m * 16 + fr) * ldc + col0;
#pragma unroll
            for (int bj = 0; bj < 2; ++bj)
#pragma unroll
                for (int n = 0; n < 2; ++n) pre[m][bj][n] = *(const f32x4*)(base + off + bj * HALF + n * 16); }
        const bool bad = st.run(acc, u, wr, wc, fr, fq, lds, wid, lane) || poison != 0u;
        const float qnan = __builtin_nanf("");
#pragma unroll
        for (int ai = 0; ai < 2; ++ai)
#pragma unroll
            for (int m = 0; m < 4; ++m) { const int r = ai * HALF + wr * 64 + m * 16 + fr; const f32x2v sr = S[r]; const size_t off = (size_t)(u.pm * BM + r) * ldc + col0;
#pragma unroll
                for (int bj = 0; bj < 2; ++bj)
#pragma unroll
                    for (int n = 0; n < 2; ++n) { const f32x4 bs = ai == 0 ? pre[m][bj][n] : *(const f32x4*)(base + off + bj * HALF + n * 16); f32x4 o = bs + (acc[ai][bj][m][n] - sr.x) * sr.y;
                        if (bad) o = (f32x4){qnan, qnan, qnan, qnan}; *(f32x4*)(out + off + bj * HALF + n * 16) = o; }
                if (m & 1) asm volatile("" ::: "memory"); }
    }
};
struct EpiLnResLn {
    static constexpr bool PERM = false, AFTER_DRAIN = true;
    const float* base; float* out; bf16_t* xn; int ldc; const float* bias; PanelStats st1, st2; unsigned poison;
    __device__ __forceinline__ void fused(f32x4 (&acc)[2][2][4][2], const Unit& u, int wr, int wc, int fr, int fq, PG8_LAS unsigned char* lds, int wid, int lane) const {
        typedef float f32x2v __attribute__((ext_vector_type(2))); typedef unsigned u32x2v __attribute__((ext_vector_type(2)));
        const PG8_LAS f32x2v* S = (const PG8_LAS f32x2v*)(lds + 8192);
        const int col0 = u.pn * BM + wc * 32 + 4 * fq;
#pragma unroll
        for (int bj = 0; bj < 2; ++bj)
#pragma unroll
            for (int n = 0; n < 2; ++n) { const f32x4 bv = bias ? *(const f32x4*)(bias + col0 + bj * HALF + n * 16) : (f32x4){0.f, 0.f, 0.f, 0.f};
#pragma unroll
                for (int ai = 0; ai < 2; ++ai)
#pragma unroll
                    for (int m = 0; m < 4; ++m) acc[ai][bj][m][n] += bv; }
        bool bad = st1.run(acc, u, wr, wc, fr, fq, lds, wid, lane) || poison != 0u;
        const float qnan = __builtin_nanf("");
#pragma unroll
        for (int ai = 0; ai < 2; ++ai)
#pragma unroll
            for (int m = 0; m < 4; ++m) { const int r = ai * HALF + wr * 64 + m * 16 + fr; const f32x2v sr = S[r]; const size_t off = (size_t)(u.pm * BM + r) * ldc + col0;
#pragma unroll
                for (int bj = 0; bj < 2; ++bj)
#pragma unroll
                    for (int n = 0; n < 2; ++n) { const f32x4 bs = *(const f32x4*)(base + off + bj * HALF + n * 16); acc[ai][bj][m][n] = bs + (acc[ai][bj][m][n] - sr.x) * sr.y; }
                asm volatile("" : "+v"(acc[ai][0][m][0]), "+v"(acc[ai][0][m][1]), "+v"(acc[ai][1][m][0]), "+v"(acc[ai][1][m][1]));
                if (m & 1) asm volatile("" ::: "memory"); }
        const bool bad1 = bad;
        bad = st2.run(acc, u, wr, wc, fr, fq, lds, wid, lane) || bad;
#pragma unroll
        for (int ai = 0; ai < 2; ++ai)
#pragma unroll
            for (int m = 0; m < 4; ++m) { const int r = ai * HALF + wr * 64 + m * 16 + fr; const f32x2v sr = S[r]; const size_t off = (size_t)(u.pm * BM + r) * ldc + col0;
#pragma unroll
                for (int bj = 0; bj < 2; ++bj)
#pragma unroll
                    for (int n = 0; n < 2; ++n) { const f32x4 x1 = acc[ai][bj][m][n]; *(f32x4*)(out + off + bj * HALF + n * 16) = bad1 ? (f32x4){qnan, qnan, qnan, qnan} : x1;
                        const f32x4 o = (x1 - sr.x) * sr.y; u32x2v w; w.x = cvt_pk_bf16(o[0], o[1]); w.y = cvt_pk_bf16(o[2], o[3]);
                        if (bad) { w.x = 0x7fc07fc0u; w.y = 0x7fc07fc0u; } *(u32x2v*)(xn + off + bj * HALF + n * 16) = w; }
                asm volatile("" ::: "memory"); }
    }
};

template <class Epi, class Sched, bool ALIGN_EPI = false, bool SP2 = false>
__device__ __forceinline__ void gemm_phase(PG8_LAS unsigned char* lds, const Gemm g, const Sched& S, const Epi& E) {
    int tid_ = threadIdx.x; asm volatile("" : "+v"(tid_));
    const int tid = tid_, wid = __builtin_amdgcn_readfirstlane(tid >> 6), lane = tid & 63, wr = wid >> 2, wc = wid & 3, fr = lane & 15, fq = lane >> 4;
    const int K = g.K, nt = K / BK;
    unsigned voffA[2], voffB[2];
#pragma unroll
    for (int i = 0; i < 2; ++i) { int R, C; stage_rc(tid * 16 + i * 8192, R, C); const int Rb = Epi::PERM ? ((R & ~31) + perm32(R & 31)) : R;
        voffA[i] = (unsigned)(R * K + C) * 2u; voffB[i] = (unsigned)(Rb * K + C) * 2u; }
    const size_t kstep = (size_t)(BK * 2);
    const size_t hstep = (size_t)HALF * K * 2;
    const size_t tstep = 2 * hstep;
    const unsigned ldsw = (unsigned)wid * 1024u;
    const int aoff = lds_byte(wr * 64 + fr, fq * 8), boff = lds_byte(wc * 32 + fr, fq * 8);
#define PG8_SA(b, h) (((b) * 2 + (h)) * HTB)
#define PG8_SB(b, h) ((4 + (b) * 2 + (h)) * HTB)
#define PG8_STAGE(bufoff, gbase, voff) do { _Pragma("unroll") for (int _i = 0; _i < 2; ++_i) \
        __builtin_amdgcn_global_load_lds((const unsigned*)((const char*)(gbase) + (voff)[_i]), (PG8_LAS unsigned*)(lds + (bufoff) + ldsw + _i * 8192), 16, 0, 0); } while (0)
#define PG8_LDA(dst, b, h) do { _Pragma("unroll") for (int m = 0; m < 4; ++m) _Pragma("unroll") for (int k = 0; k < 2; ++k) dst[m][k] = *(const PG8_LAS bf16x8*)(lds + PG8_SA(b, h) + aoff + m * 2048 + k * 1024); } while (0)
#define PG8_LDB(dst, b, h) do { _Pragma("unroll") for (int n = 0; n < 2; ++n) _Pragma("unroll") for (int k = 0; k < 2; ++k) dst[n][k] = *(const PG8_LAS bf16x8*)(lds + PG8_SB(b, h) + boff + n * 2048 + k * 1024); } while (0)
#define PG8_MMA(ai, bj, At, Bt) do { __builtin_amdgcn_s_setprio(1); _Pragma("unroll") for (int m = 0; m < 4; ++m) _Pragma("unroll") for (int n = 0; n < 2; ++n) _Pragma("unroll") for (int k = 0; k < 2; ++k) \
        acc[ai][bj][m][n] = __builtin_amdgcn_mfma_f32_16x16x32_f16(__builtin_bit_cast(half8, Bt[n][k]), __builtin_bit_cast(half8, At[m][k]), acc[ai][bj][m][n], 0, 0, 0); __builtin_amdgcn_s_setprio(0); } while (0)
#define PG8_WAIT_V(n) asm volatile("s_waitcnt vmcnt(" #n ")" ::: "memory")
#define PG8_WAIT_L(n) asm volatile("s_waitcnt lgkmcnt(" #n ")" ::: "memory")
#define PG8_BAR __builtin_amdgcn_s_barrier()
#define PG8_SCHED __builtin_amdgcn_sched_barrier(0)
    Unit cur, nxt; int ui = 0;
    if (!S.next(0, cur)) return;
    f32x4 acc[2][2][4][2];
#pragma unroll
    for (int a = 0; a < 2; ++a)
#pragma unroll
        for (int b = 0; b < 2; ++b)
#pragma unroll
            for (int m = 0; m < 4; ++m)
#pragma unroll
                for (int n = 0; n < 2; ++n) acc[a][b][m][n] = (f32x4){0.f, 0.f, 0.f, 0.f};
    bf16x8 At[4][2], B0[2][2], B1[2][2];
    const char* cA = (const char*)g.A + (size_t)cur.pm * tstep; const char* cB = (const char*)g.Bt + (size_t)cur.pn * tstep;
    S.a_ready(cur);
    if constexpr (SP2) {
        PG8_STAGE(PG8_SB(0, 0), cB, voffB); PG8_STAGE(PG8_SB(0, 1), cB + hstep, voffB); PG8_STAGE(PG8_SA(0, 0), cA, voffA); PG8_STAGE(PG8_SA(0, 1), cA + hstep, voffA);
        if (wr == 1) PG8_BAR;
        PG8_WAIT_V(2); PG8_BAR;
        PG8_STAGE(PG8_SB(1, 0), cB + kstep, voffB); PG8_STAGE(PG8_SA(1, 0), cA + kstep, voffA); PG8_STAGE(PG8_SB(1, 1), cB + hstep + kstep, voffB);
        PG8_WAIT_V(6); PG8_BAR;
    } else {
        PG8_STAGE(PG8_SB(0, 0), cB, voffB); PG8_STAGE(PG8_SA(0, 0), cA, voffA); PG8_STAGE(PG8_SB(0, 1), cB + hstep, voffB); PG8_STAGE(PG8_SA(0, 1), cA + hstep, voffA);
        if (wr == 1) PG8_BAR;
        PG8_WAIT_V(4); PG8_BAR;
        PG8_STAGE(PG8_SB(1, 0), cB + kstep, voffB); PG8_STAGE(PG8_SA(1, 0), cA + kstep, voffA); PG8_STAGE(PG8_SB(1, 1), cB + hstep + kstep, voffB);
        PG8_WAIT_V(6); PG8_BAR;
    }
    for (;;) {
        const bool has_next = S.next(ui + 1, nxt);
        const char* nA = has_next ? (const char*)g.A + (size_t)nxt.pm * tstep : cA; const char* nB = has_next ? (const char*)g.Bt + (size_t)nxt.pn * tstep : cB;
        for (int t = 0; t < nt; t += 2) {
            const bool last = (t == nt - 2);
            const char* a1 = cA + (size_t)(t + 1) * kstep;
            const char* a2 = last ? nA : cA + (size_t)(t + 2) * kstep; const char* b2 = last ? nB : cB + (size_t)(t + 2) * kstep;
            const char* a3 = a2 + kstep; const char* b3 = b2 + kstep;
            if (last && has_next) S.a_ready(nxt);
            if constexpr (SP2) {
            PG8_LDB(B0, 0, 0); PG8_LDB(B1, 0, 1); PG8_SCHED; PG8_LDA(At, 0, 0); PG8_STAGE(PG8_SA(1, 1), a1 + hstep, voffA);
            PG8_WAIT_V(8); PG8_WAIT_L(0); PG8_BAR; PG8_MMA(0, 0, At, B0); PG8_MMA(0, 1, At, B1); PG8_BAR; PG8_SCHED;
            PG8_LDA(At, 0, 1); PG8_STAGE(PG8_SB(0, 0), b2, voffB); PG8_STAGE(PG8_SB(0, 1), b2 + hstep, voffB); PG8_STAGE(PG8_SA(0, 0), a2, voffA);
            PG8_WAIT_V(8); PG8_WAIT_L(0); PG8_BAR; PG8_MMA(1, 0, At, B0); PG8_MMA(1, 1, At, B1); PG8_BAR; PG8_SCHED;
            PG8_LDB(B0, 1, 0); PG8_LDB(B1, 1, 1); PG8_SCHED; PG8_LDA(At, 1, 0); PG8_STAGE(PG8_SA(0, 1), a2 + hstep, voffA);
            PG8_WAIT_V(8); PG8_WAIT_L(0); PG8_BAR; PG8_MMA(0, 0, At, B0); PG8_MMA(0, 1, At, B1); PG8_BAR; PG8_SCHED;
            PG8_LDA(At, 1, 1); PG8_STAGE(PG8_SB(1, 0), b3, voffB); PG8_STAGE(PG8_SB(1, 1), b3 + hstep, voffB); PG8_STAGE(PG8_SA(1, 0), a3, voffA);
            PG8_WAIT_V(8); PG8_WAIT_L(0); PG8_BAR; PG8_MMA(1, 0, At, B0); PG8_MMA(1, 1, At, B1); PG8_BAR; PG8_SCHED;
            } else {
            PG8_LDB(B0, 0, 0); PG8_SCHED; PG8_LDA(At, 0, 0); PG8_STAGE(PG8_SA(1, 1), a1 + hstep, voffA);
            PG8_WAIT_L(8); PG8_BAR; PG8_WAIT_L(0); PG8_MMA(0, 0, At, B0); PG8_BAR; PG8_SCHED;
            PG8_LDB(B1, 0, 1); PG8_STAGE(PG8_SB(0, 0), b2, voffB);
            PG8_BAR; PG8_WAIT_L(0); PG8_MMA(0, 1, At, B1); PG8_BAR;
            PG8_LDA(At, 0, 1); PG8_STAGE(PG8_SA(0, 0), a2, voffA);
            PG8_BAR; PG8_WAIT_L(0); PG8_MMA(1, 0, At, B0); PG8_BAR; PG8_SCHED;
            PG8_STAGE(PG8_SB(0, 1), b2 + hstep, voffB);
            PG8_WAIT_V(6); PG8_BAR; PG8_MMA(1, 1, At, B1); PG8_BAR;
            PG8_LDB(B0, 1, 0); PG8_SCHED; PG8_LDA(At, 1, 0); PG8_STAGE(PG8_SA(0, 1), a2 + hstep, voffA);
            PG8_WAIT_L(8); PG8_BAR; PG8_WAIT_L(0); PG8_MMA(0, 0, At, B0); PG8_BAR; PG8_SCHED;
            PG8_LDB(B1, 1, 1); PG8_STAGE(PG8_SB(1, 0), b3, voffB);
            PG8_BAR; PG8_WAIT_L(0); PG8_MMA(0, 1, At, B1); PG8_BAR;
            PG8_LDA(At, 1, 1); PG8_STAGE(PG8_SA(1, 0), a3, voffA);
            PG8_BAR; PG8_WAIT_L(0); PG8_MMA(1, 0, At, B0); PG8_BAR; PG8_SCHED;
            PG8_STAGE(PG8_SB(1, 1), b3 + hstep, voffB);
            PG8_WAIT_V(6); PG8_BAR; PG8_MMA(1, 1, At, B1); PG8_BAR;
            }
        }
        if constexpr (ALIGN_EPI) { if (wr == 0) PG8_BAR; }
        if constexpr (!Epi::AFTER_DRAIN) { E(acc, cur, wr, wc, fr, fq); S.done(cur); }
        if (!has_next) break;
#pragma unroll
        for (int a = 0; a < 2; ++a)
#pragma unroll
            for (int b = 0; b < 2; ++b)
#pragma unroll
                for (int m = 0; m < 4; ++m)
#pragma unroll
                    for (int n = 0; n < 2; ++n) acc[a][b][m][n] = (f32x4){0.f, 0.f, 0.f, 0.f};
        cur = nxt; cA = nA; cB = nB; ++ui;
        if constexpr (ALIGN_EPI) { if (wr == 1) PG8_BAR; }
    }
    PG8_WAIT_V(0);
    if constexpr (!ALIGN_EPI) { if (wr == 0) PG8_BAR; }
    PG8_BAR;
    if constexpr (Epi::AFTER_DRAIN) { E.fused(acc, cur, wr, wc, fr, fq, lds, wid, lane); S.done(cur); }
#undef PG8_SA
#undef PG8_SB
#undef PG8_STAGE
#undef PG8_LDA
#undef PG8_LDB
#undef PG8_MMA
#undef PG8_WAIT_V
#undef PG8_WAIT_L
#undef PG8_BAR
#undef PG8_SCHED
}
}

#define LAS __attribute__((address_space(3)))
typedef unsigned short bf16;
typedef float f32x4 __attribute__((ext_vector_type(4)));
typedef unsigned u32x4 __attribute__((ext_vector_type(4)));
typedef unsigned u32x2 __attribute__((ext_vector_type(2)));
constexpr int D = 1024, NB = 16, SEQ = 4096, M = NB * SEQ, CH = 64, NCHUNK = SEQ / CH;
constexpr int DIN = 3740, NP = 3840;
constexpr float LN_EPS = 1e-5f, NORM_EPS = 1e-6f, ALPHA = 1.41421356237f;
constexpr int A_BASE = 0;
constexpr int C_BASE = 1024;
constexpr int B_BASE = 2560;
constexpr int LR_COL = 3712, AC_COL = 3728, BC_COL = 3734;
__host__ __device__ inline int old_col(int n) {
    if (n < 1024) { const int h = n >> 8, r = n & 255, seg = r >> 6, c = r & 63; return seg * 256 + h * 64 + c; }
    if (n < 2560) { const int m = n - 1024, h = m >> 8, r = m & 255, seg = r >> 6, c = r & 63; return seg < 3 ? 2192 + seg * 384 + h * 64 + c : 3356 + h * 64 + c; }
    if (n < 3712) { const int m = n - 2560, h = m / 288, r = m % 288;
        if (r < 48) return 1024 + h * 48 + r; if (r < 96) return 1216 + h * 48 + (r - 48); if (r < 192) return 1408 + h * 96 + (r - 96); return 1808 + h * 96 + (r - 192); }
    if (n < 3728) return 1792 + (n - 3712);
    if (n < 3734) return 3344 + (n - 3728);
    if (n < 3740) return 3350 + (n - 3734);
    return -1;
}
constexpr size_t MiB = 1u << 20;
constexpr size_t WS_CTL = 0, WS_WIN = 1 * MiB, WS_WOUT = 16 * MiB, WS_MOD = 20 * MiB, WS_LB = 21 * MiB;
constexpr size_t WS_HY = 32 * MiB, WS_X1 = 160 * MiB, WS_PROJ = 416 * MiB, WS_END = 896 * MiB;
constexpr int LDS_BYTES = 147456;
constexpr int NTHREADS = 512;

struct Args { const float* in[17]; float* out; unsigned char* ws; int ph_lo, ph_hi; };
enum { I_X = 0, I_C, I_WIN, I_WOUT, I_ADAW, I_ADAB, I_LNG, I_LNB, I_LBL, I_WGK, I_BGK, I_CONV, I_ALOG, I_DTB, I_GA, I_GB, I_GC };

__device__ __forceinline__ unsigned f2bf(float f) { return (unsigned)__builtin_bit_cast(unsigned short, (_Float16)f); }
__device__ __forceinline__ unsigned pk2(float lo, float hi) { typedef _Float16 h2 __attribute__((ext_vector_type(2))); h2 v; v.x = (_Float16)lo; v.y = (_Float16)hi; return __builtin_bit_cast(unsigned, v); }
__device__ __forceinline__ float bf2f(bf16 b) { return (float)__builtin_bit_cast(_Float16, b); }
__device__ __forceinline__ float wave_sum(float v) {
#pragma unroll
    for (int o = 1; o < 64; o <<= 1) v += __shfl_xor(v, o);
    return v;
}
__device__ __forceinline__ float sigmoidf_(float x) { return 1.0f / (1.0f + __expf(-x)); }
__device__ __forceinline__ float siluf_(float x) { return x / (1.0f + __expf(-x)); }
__device__ __forceinline__ float softplusf_(float x) { return x > 20.f ? x : log1pf(__expf(x)); }
__device__ __forceinline__ float logsigmoidf_(float x) { return x < 0.f ? x - log1pf(__expf(x)) : -log1pf(__expf(-x)); }

__device__ __forceinline__ void p0_prep(const Args& a, unsigned char* lds_g) {
    int tid = threadIdx.x; asm volatile("" : "+v"(tid)); const int G = gridDim.x, bid = blockIdx.x;
    unsigned char* ws = a.ws;
    if (bid < 192) {
        float* cact = (float*)lds_g;
        float* part = cact + 16 * 1024;
        const float* c = a.in[I_C];
        for (int i = tid; i < 16 * 1024; i += NTHREADS) cact[i] = siluf_(c[i]);
        __syncthreads();
        const int l = bid / 96, j0 = (bid % 96) * 32, col = tid & 31, ks = tid >> 5;
        const float* W = a.in[I_ADAW] + (size_t)l * 1024 * 3072 + j0 + col;
        float acc[16];
#pragma unroll
        for (int b = 0; b < 16; ++b) acc[b] = 0.f;
        for (int k = ks * 64; k < ks * 64 + 64; ++k) {
            const float w = W[(size_t)k * 3072];
#pragma unroll
            for (int b = 0; b < 16; ++b) acc[b] += cact[b * 1024 + k] * w;
        }
#pragma unroll
        for (int b = 0; b < 16; ++b) part[(ks * 16 + b) * 32 + col] = acc[b];
        __syncthreads();
        { const int b = tid >> 5; float s = 0.f;
#pragma unroll
          for (int k2 = 0; k2 < 16; ++k2) s += part[(k2 * 16 + b) * 32 + col];
          s += a.in[I_ADAB][l * 3072 + j0 + col];
          ((float*)(ws + WS_MOD))[(size_t)(l * 16 + b) * 3072 + j0 + col] = s; }
        __syncthreads();
    }
    if (bid == 255) {
        const int l = tid >> 8, cc = tid & 255;
        const float l0 = a.in[I_LBL][cc], l1 = a.in[I_LBL][256 + cc];
        ((float*)(ws + WS_LB))[tid] = l == 0 ? 0.f : 1.0f / (1.0f + __expf(l0 - l1));
    }
    {
        const size_t gt = (size_t)bid * NTHREADS + tid, GT = (size_t)G * NTHREADS;
        bf16* WinT = (bf16*)(ws + WS_WIN);
        for (size_t idx = gt; idx < (size_t)2 * 128 * NP; idx += GT) {
            const int n = (int)(idx % NP), kb = (int)((idx / NP) % 128), l = (int)(idx / ((size_t)NP * 128));
            const int oc = old_col(n);
            float v[8];
#pragma unroll
            for (int j = 0; j < 8; ++j) v[j] = oc >= 0 ? a.in[I_WIN][((size_t)l * 1024 + kb * 8 + j) * DIN + oc] : 0.f;
            u32x4 o; o.x = pk2(v[0], v[1]); o.y = pk2(v[2], v[3]); o.z = pk2(v[4], v[5]); o.w = pk2(v[6], v[7]);
            *(u32x4*)(WinT + ((size_t)l * NP + n) * 1024 + kb * 8) = o;
        }
        bf16* WoutT = (bf16*)(ws + WS_WOUT);
        for (size_t idx = gt; idx < (size_t)2 * 128 * 1024; idx += GT) {
            const int n = (int)(idx % 1024), kb = (int)((idx / 1024) % 128), l = (int)(idx / ((size_t)1024 * 128));
            float v[8];
#pragma unroll
            for (int j = 0; j < 8; ++j) v[j] = a.in[I_WOUT][((size_t)l * 1024 + kb * 8 + j) * 1024 + n];
            u32x4 o; o.x = pk2(v[0], v[1]); o.y = pk2(v[2], v[3]); o.z = pk2(v[4], v[5]); o.w = pk2(v[6], v[7]);
            *(u32x4*)(WoutT + ((size_t)l * 1024 + n) * 1024 + kb * 8) = o;
        }
    }
}

template <int MODE>
__device__ __forceinline__ void ln_rows(const float* src, float* xo, bf16* hout, const float* lng, const float* lnb, const float* mod  ) {
    int tid = threadIdx.x; asm volatile("" : "+v"(tid));
    const int lane = tid & 63, wave = tid >> 6;
    const int gw = blockIdx.x * 8 + wave, NGW = gridDim.x * 8;
    for (int m = gw; m < M; m += NGW) {
        const f32x4* xr = (const f32x4*)(src + (size_t)m * D) + lane;
        f32x4 v[4]; float s = 0.f;
#pragma unroll
        for (int j = 0; j < 4; ++j) { v[j] = xr[64 * j]; s += (v[j].x + v[j].y) + (v[j].z + v[j].w); }
        float mean = wave_sum(s) * (1.f / D); float s2 = 0.f;
#pragma unroll
        for (int j = 0; j < 4; ++j) { v[j] = v[j] - mean; s2 += (v[j].x * v[j].x + v[j].y * v[j].y) + (v[j].z * v[j].z + v[j].w * v[j].w); }
        float rstd = 1.f / sqrtf(wave_sum(s2) * (1.f / D) + LN_EPS);
        const int b = m >> 12;
        if (MODE == 1) {
            s = 0.f;
#pragma unroll
            for (int j = 0; j < 4; ++j) { const f32x4 g = *((const f32x4*)lng + lane + 64 * j), bb = *((const f32x4*)lnb + lane + 64 * j);
                v[j] = v[j] * rstd * g + bb; *((f32x4*)(xo + (size_t)m * D) + lane + 64 * j) = v[j]; s += (v[j].x + v[j].y) + (v[j].z + v[j].w); }
            if (!hout) continue;
            mean = wave_sum(s) * (1.f / D); s2 = 0.f;
#pragma unroll
            for (int j = 0; j < 4; ++j) { v[j] = v[j] - mean; s2 += (v[j].x * v[j].x + v[j].y * v[j].y) + (v[j].z * v[j].z + v[j].w * v[j].w); }
            rstd = 1.f / sqrtf(wave_sum(s2) * (1.f / D) + LN_EPS);
        }
        const float* mb = mod + (size_t)b * 3072;
#pragma unroll
        for (int j = 0; j < 4; ++j) { const f32x4 sh = *((const f32x4*)mb + lane + 64 * j), sc = *((const f32x4*)(mb + 1024) + lane + 64 * j);
            const f32x4 h = v[j] * rstd * (sc + 1.0f) + sh;
            u32x2 w; w.x = pk2(h.x, h.y); w.y = pk2(h.z, h.w);
            *((u32x2*)(hout + (size_t)m * D) + lane + 64 * j) = w; }
    }
}

struct EpiRes {
    static constexpr bool PERM = false, AFTER_DRAIN = false;
    const float* xin; float* res; const float* gate;
    __device__ __forceinline__ void operator()(const pg8::f32x4 (&acc)[2][2][4][2], const pg8::Unit& u, int wr, int wc, int fr, int fq) const {
        const int row0 = u.pm * 256 + wr * 64 + fr, col0 = u.pn * 256 + wc * 32 + 4 * fq;
#pragma unroll
        for (int ai = 0; ai < 2; ++ai)
#pragma unroll
            for (int m = 0; m < 4; ++m) { const int row = row0 + ai * 128 + m * 16; const int b = row >> 12;
#pragma unroll
                for (int bj = 0; bj < 2; ++bj)
#pragma unroll
                    for (int n = 0; n < 2; ++n) { const int col = col0 + bj * 128 + n * 16;
                        const f32x4 g = *(const f32x4*)(gate + (size_t)b * 3072 + col), xv = *(const f32x4*)(xin + (size_t)row * D + col);
                        *(f32x4*)(res + (size_t)row * D + col) = xv * ALPHA + g * acc[ai][bj][m][n]; } }
    }
};

template <int DK, int DV, bool ISA>
__device__ __forceinline__ void mix_gla_base(const Args& a, int layer, int b, int h, float* lds) {
    constexpr int PK = DK + 1, PV = DV + 1;
    float* q = lds; float* k = q + 64 * PK; float* bc = k + 64 * PK; float* v = bc + 64 * PK; float* sc = v + 64 * PV; float* S = sc + 64 * 65; float* o = S + DK * DV; float* rinv = o + 64 * PV;
    int tid0 = threadIdx.x; asm volatile("" : "+v"(tid0));
    const bf16* proj = (const bf16*)(a.ws + WS_PROJ);
    bf16* y = (bf16*)(a.ws + WS_HY);
    const int base = ISA ? A_BASE + 256 * h : B_BASE + 288 * h;
    const int vcol = ISA ? base + 128 : base + 96, zcol = ISA ? base + 192 : base + 192;
    const int ycol = ISA ? 64 * h : 256 + 96 * h;
    const float* gain = ISA ? a.in[I_GA] + layer * 64 : a.in[I_GB] + layer * 96;
    const float* lb = (const float*)(a.ws + WS_LB) + layer * 256 + h * 64;
    const float* wgk = a.in[I_WGK] + (size_t)layer * 16 * 192 + h * 48;
    const float* bgk = a.in[I_BGK] + layer * 192 + h * 48;
    for (int i = tid0; i < DK * DV; i += NTHREADS) S[i] = 0.f;
    for (int n = 0; n < NCHUNK; ++n) {
        int tid = tid0; asm volatile("" : "+v"(tid));
        const size_t t0 = (size_t)b * SEQ + (size_t)n * 64;
        __syncthreads();
        for (int i = tid; i < 64 * DK; i += NTHREADS) { const int t = i / DK, c = i % DK; const bf16* row = proj + (t0 + t) * NP;
            if (ISA) { const float qr = bf2f(row[base + c]), fl = bf2f(row[base + 64 + c]); const float sg = sigmoidf_(fl), lbv = lb[c];
                q[t * PK + c] = siluf_(qr); const float f = lbv + (1.f - lbv) * sg; bc[t * PK + c] = __logf(fmaxf(f, 1e-30f)); k[t * PK + c] = (1.f - lbv) * sigmoidf_(-fl); }
            else { q[t * PK + c] = bf2f(row[base + c]) * 0.14433756729740643f; k[t * PK + c] = bf2f(row[base + 48 + c]);
                float s = bgk[c];
#pragma unroll
                for (int r = 0; r < 16; ++r) s += bf2f(row[LR_COL + r]) * wgk[r * 192 + c];
                bc[t * PK + c] = logsigmoidf_(s) * (1.0f / 16.0f); } }
        for (int i = tid; i < 64 * DV; i += NTHREADS) { const int t = i / DV, c = i % DV; v[t * PV + c] = bf2f(proj[(t0 + t) * NP + vcol + c]); }
        __syncthreads();
        if (tid < DK) { float run = 0.f; for (int t = 0; t < 64; ++t) { run += bc[t * PK + tid]; bc[t * PK + tid] = run; } }
        __syncthreads();
        for (int i = tid; i < 64 * 64; i += NTHREADS) { const int t = i >> 6, s = i & 63; float acc = 0.f;
            if (s <= t) for (int c = 0; c < DK; ++c) acc += q[t * PK + c] * k[s * PK + c] * __expf(bc[t * PK + c] - bc[s * PK + c]);
            sc[t * 65 + s] = acc; }
        __syncthreads();
        for (int i = tid; i < 64 * DV; i += NTHREADS) { const int t = i / DV, c = i % DV; float acc = 0.f;
            for (int s = 0; s <= t; ++s) acc += sc[t * 65 + s] * v[s * PV + c];
            for (int kk = 0; kk < DK; ++kk) acc += q[t * PK + kk] * __expf(bc[t * PK + kk]) * S[kk * DV + c];
            o[t * PV + c] = acc; }
        __syncthreads();
        for (int i = tid; i < DK * DV; i += NTHREADS) { const int kk = i / DV, c = i % DV; const float bl = bc[63 * PK + kk]; float acc = __expf(bl) * S[i];
            for (int s = 0; s < 64; ++s) acc += k[s * PK + kk] * __expf(bl - bc[s * PK + kk]) * v[s * PV + c];
            S[i] = acc; }
        if (tid < 64) { float s2 = 0.f; for (int c = 0; c < DV; ++c) s2 += o[tid * PV + c] * o[tid * PV + c]; rinv[tid] = 1.0f / sqrtf(s2 * (1.0f / DV) + NORM_EPS); }
        __syncthreads();
        for (int i = tid; i < 64 * DV; i += NTHREADS) { const int t = i / DV, c = i % DV; const float z = bf2f(proj[(t0 + t) * NP + zcol + c]);
            y[(t0 + t) * D + ycol + c] = (bf16)f2bf(o[t * PV + c] * rinv[t] * gain[c] * siluf_(z)); }
    }
}
__device__ __forceinline__ void mix_gdn_base(const Args& a, int layer, int b, int h, float* lds) {
    constexpr int P = 65;
    float* q = lds; float* k = q + 64 * P; float* v = k + 64 * P; float* L = v + 64 * P; float* at = L + 64 * P; float* U = at + 64 * P; float* W = U + 64 * P; float* S = W + 64 * P;
    float* bc = S + 64 * 64; float* beta = bc + 64; float* g = beta + 64; float* rinv = g + 64;
    int tid0 = threadIdx.x; asm volatile("" : "+v"(tid0));
    const bf16* proj = (const bf16*)(a.ws + WS_PROJ);
    bf16* y = (bf16*)(a.ws + WS_HY);
    const int base = C_BASE + 256 * h, ycol = 640 + 64 * h;
    const float* gain = a.in[I_GC] + layer * 64;
    const float* cw = a.in[I_CONV] + (size_t)layer * 4 * 1152;
    const float alog = a.in[I_ALOG][layer * 6 + h], dtb = a.in[I_DTB][layer * 6 + h];
    for (int i = tid0; i < 64 * 64; i += NTHREADS) S[i] = 0.f;
    for (int n = 0; n < NCHUNK; ++n) {
        int tid = tid0; asm volatile("" : "+v"(tid));
        const size_t t0 = (size_t)b * SEQ + (size_t)n * 64;
        __syncthreads();
        for (int i = tid; i < 64 * 192; i += NTHREADS) { const int t = i / 192, cc = i % 192, seg = cc >> 6, c = cc & 63; const int ch = seg * 384 + h * 64 + c; float acc = 0.f;
#pragma unroll
            for (int j = 0; j < 4; ++j) { const int p = n * 64 + t - 3 + j; if (p >= 0) acc += cw[j * 1152 + ch] * bf2f(proj[((size_t)b * SEQ + p) * NP + base + seg * 64 + c]); }
            const float r = siluf_(acc); (seg == 0 ? q : seg == 1 ? k : v)[t * P + c] = r; }
        if (tid < 64) { const bf16* row = proj + (t0 + tid) * NP; const float av = bf2f(row[AC_COL + h]), bv = bf2f(row[BC_COL + h]);
            g[tid] = -__expf(alog) * softplusf_(av + dtb); beta[tid] = sigmoidf_(bv); }
        __syncthreads();
        if (tid < 64) { float sq = 0.f, sk = 0.f; for (int c = 0; c < 64; ++c) { sq += q[tid * P + c] * q[tid * P + c]; sk += k[tid * P + c] * k[tid * P + c]; }
            const float nq = 0.125f / sqrtf(sq + NORM_EPS), nk = 1.0f / sqrtf(sk + NORM_EPS);
            for (int c = 0; c < 64; ++c) { q[tid * P + c] *= nq; k[tid * P + c] *= nk; } }
        if (tid == 64) { float run = 0.f; for (int t = 0; t < 64; ++t) { run += g[t]; bc[t] = run; } }
        __syncthreads();
        for (int i = tid; i < 64 * 64; i += NTHREADS) { const int t = i >> 6, s = i & 63; float kk = 0.f, qk = 0.f;
            if (s <= t) { for (int c = 0; c < 64; ++c) { kk += k[t * P + c] * k[s * P + c]; qk += q[t * P + c] * k[s * P + c]; } }
            const float dec = s <= t ? __expf(bc[t] - bc[s]) : 0.f;
            L[t * P + s] = s < t ? beta[t] * kk * dec : 0.f; at[t * P + s] = qk * dec;
            U[t * P + s] = v[t * P + s] * beta[t]; W[t * P + s] = k[t * P + s] * beta[t] * __expf(bc[t]); }
        __syncthreads();
        if (tid < 128) { float* X = (tid < 64 ? U : W); const int c = tid & 63;
            for (int t = 1; t < 64; ++t) { float acc = X[t * P + c]; for (int s = 0; s < t; ++s) acc -= L[t * P + s] * X[s * P + c]; X[t * P + c] = acc; } }
        __syncthreads();
        for (int i = tid; i < 64 * 64; i += NTHREADS) { const int t = i >> 6, c = i & 63; float acc = U[t * P + c];
            for (int kk = 0; kk < 64; ++kk) acc -= W[t * P + kk] * S[kk * 64 + c];
            U[t * P + c] = acc; }
        __syncthreads();
        for (int i = tid; i < 64 * 64; i += NTHREADS) { const int t = i >> 6, c = i & 63; float acc = 0.f; const float eb = __expf(bc[t]);
            for (int kk = 0; kk < 64; ++kk) acc += q[t * P + kk] * eb * S[kk * 64 + c];
            for (int s = 0; s <= t; ++s) acc += at[t * P + s] * U[s * P + c];
            L[t * P + c] = acc; }
        __syncthreads();
        for (int i = tid; i < 64 * 64; i += NTHREADS) { const int kk = i >> 6, c = i & 63; const float bl = bc[63]; float acc = __expf(bl) * S[i];
            for (int s = 0; s < 64; ++s) acc += k[s * P + kk] * __expf(bl - bc[s]) * U[s * P + c];
            S[i] = acc; }
        if (tid < 64) { float s2 = 0.f; for (int c = 0; c < 64; ++c) s2 += L[tid * P + c] * L[tid * P + c]; rinv[tid] = 1.0f / sqrtf(s2 * (1.0f / 64) + NORM_EPS); }
        __syncthreads();
        for (int i = tid; i < 64 * 64; i += NTHREADS) { const int t = i >> 6, c = i & 63; const float z = bf2f(proj[(t0 + t) * NP + base + 192 + c]);
            y[(t0 + t) * D + ycol + c] = (bf16)f2bf(L[t * P + c] * rinv[t] * gain[c] * siluf_(z)); }
    }
}

typedef _Float16 half8 __attribute__((ext_vector_type(8)));
typedef _Float16 half4 __attribute__((ext_vector_type(4)));
typedef short bfr8 __attribute__((ext_vector_type(8)));
constexpr int RS = 72;
constexpr int TILEB = 64 * RS * 2;
#define LDS_AT(T, off) (*(LAS T*)(L + (off)))
__device__ __forceinline__ f32x4 mfma32h(half8 a, half8 b, f32x4 c) { return __builtin_amdgcn_mfma_f32_16x16x32_f16(a, b, c, 0, 0, 0); }
__device__ __forceinline__ f32x4 mfma16h(half4 a, half4 b, f32x4 c) { return __builtin_amdgcn_mfma_f32_16x16x16f16(a, b, c, 0, 0, 0); }
__device__ __forceinline__ half4 to_h4(f32x4 x) { half4 r; r[0] = (_Float16)x[0]; r[1] = (_Float16)x[1]; r[2] = (_Float16)x[2]; r[3] = (_Float16)x[3]; return r; }
__device__ __forceinline__ half8 acc2op(f32x4 x0, f32x4 x1) { half8 r; r[0] = (_Float16)x0[0]; r[1] = (_Float16)x0[1]; r[2] = (_Float16)x0[2]; r[3] = (_Float16)x0[3];
    r[4] = (_Float16)x1[0]; r[5] = (_Float16)x1[1]; r[6] = (_Float16)x1[2]; r[7] = (_Float16)x1[3]; return r; }
__device__ __forceinline__ int swz8(int row) { return 8 * ((row >> 3) & 7); }
__device__ __forceinline__ half8 frag_std(LAS unsigned char* L, int tile, int row, int kb, int q, int sw) { return LDS_AT(half8, tile + row * (RS * 2) + (((32 * kb + 8 * q) ^ sw) * 2)); }
__device__ __forceinline__ half8 frag_perm(LAS unsigned char* L, int tile, int row, int kb, int q, int sw) {
    const half4 lo = LDS_AT(half4, tile + row * (RS * 2) + (((32 * kb + 4 * q) ^ sw) * 2)), hi = LDS_AT(half4, tile + row * (RS * 2) + (((32 * kb + 16 + 4 * q) ^ sw) * 2));
    half8 r; r[0] = lo[0]; r[1] = lo[1]; r[2] = lo[2]; r[3] = lo[3]; r[4] = hi[0]; r[5] = hi[1]; r[6] = hi[2]; r[7] = hi[3]; return r; }
__device__ __forceinline__ float h2f_lo(unsigned w) { return (float)__builtin_bit_cast(_Float16, (unsigned short)(w & 0xffffu)); }
__device__ __forceinline__ float h2f_hi(unsigned w) { return (float)__builtin_bit_cast(_Float16, (unsigned short)(w >> 16)); }
#define WG_BAR() do { asm volatile("s_waitcnt lgkmcnt(0)" ::: "memory"); __builtin_amdgcn_s_barrier(); asm volatile("" ::: "memory"); } while (0)

__device__ __forceinline__ void mix_gdn_fast(const Args& a, int layer, int b, int h, LAS unsigned char* L) {
    constexpr int O_K = 0, O_Q = TILEB, O_KT = 2 * TILEB, O_VB = 3 * TILEB, O_G = 4 * TILEB, O_AT = 5 * TILEB, O_OB = 6 * TILEB, OBS = 68;
    constexpr int O_VEC = O_OB + 64 * OBS * 4;
    constexpr int V_BC = O_VEC, V_EB = O_VEC + 256, V_CB = O_VEC + 512, V_DB = O_VEC + 768, V_BE = O_VEC + 1024, V_D = O_VEC + 1280;
    constexpr int O_CW = O_VEC + 1536;
    int tid0 = threadIdx.x; asm volatile("" : "+v"(tid0));
    const bf16* proj = (const bf16*)(a.ws + WS_PROJ);
    bf16* y = (bf16*)(a.ws + WS_HY);
    const int base = C_BASE + 256 * h, ycol = 640 + 64 * h;
    const float* gain = a.in[I_GC] + layer * 64;
    const float expA = __expf(a.in[I_ALOG][layer * 6 + h]), dtb = a.in[I_DTB][layer * 6 + h];
    for (int i = tid0; i < 2 * TILEB / 16; i += NTHREADS) LDS_AT(u32x4, O_G + 16 * i) = (u32x4){0u, 0u, 0u, 0u};
    for (int i = tid0; i < 768; i += NTHREADS) { const int j = i / 192, cc = i % 192, seg = cc >> 6, c = cc & 63; LDS_AT(float, O_CW + 4 * i) = a.in[I_CONV][(size_t)layer * 4 * 1152 + j * 1152 + seg * 384 + h * 64 + c]; }
    f32x4 S[4];
#pragma unroll
    for (int i = 0; i < 4; ++i) S[i] = (f32x4){0.f, 0.f, 0.f, 0.f};
    u32x4 raw[3][4]; u32x4 zraw, zprev = (u32x4){0u, 0u, 0u, 0u}; unsigned short ga = 0, gb = 0;
    const size_t tok0 = (size_t)b * SEQ;
#define GDN_PREFETCH(n_) do { const int tt_ = tid0 >> 3, cg_ = tid0 & 7; \
        _Pragma("unroll") for (int j_ = 0; j_ < 4; ++j_) { const int p_ = (n_) * 64 + tt_ - 3 + j_; \
            _Pragma("unroll") for (int s_ = 0; s_ < 3; ++s_) raw[s_][j_] = p_ >= 0 ? *(const u32x4*)(proj + (tok0 + p_) * NP + base + s_ * 64 + 8 * cg_) : (u32x4){0u, 0u, 0u, 0u}; } \
        zraw = *(const u32x4*)(proj + (tok0 + (n_) * 64 + tt_) * NP + base + 192 + 8 * cg_); \
        ga = proj[(tok0 + (n_) * 64 + (tid0 & 63)) * NP + AC_COL + h]; gb = proj[(tok0 + (n_) * 64 + (tid0 & 63)) * NP + BC_COL + h]; } while (0)
    GDN_PREFETCH(0);
    WG_BAR();
#pragma unroll 1
    for (int n = 0; n <= NCHUNK; ++n) {
        int tid = tid0; asm volatile("" : "+v"(tid));
        const int lane = tid & 63, wv = __builtin_amdgcn_readfirstlane(tid >> 6), t = tid >> 3, cg = tid & 7;
        if (n > 0) {
            const f32x4 o0 = LDS_AT(f32x4, O_OB + (t * OBS + 8 * cg) * 4), o1 = LDS_AT(f32x4, O_OB + (t * OBS + 8 * cg + 4) * 4);
            float s2 = (o0[0] * o0[0] + o0[1] * o0[1]) + (o0[2] * o0[2] + o0[3] * o0[3]) + (o1[0] * o1[0] + o1[1] * o1[1]) + (o1[2] * o1[2] + o1[3] * o1[3]);
            s2 += __shfl_xor(s2, 1); s2 += __shfl_xor(s2, 2); s2 += __shfl_xor(s2, 4);
            const float rinv = 1.0f / sqrtf(s2 * (1.0f / 64) + NORM_EPS);
            const f32x4 g0 = *(const f32x4*)(gain + 8 * cg), g1 = *(const f32x4*)(gain + 8 * cg + 4);
            u32x4 w;
            w.x = pk2(o0[0] * rinv * g0[0] * siluf_(h2f_lo(zprev.x)), o0[1] * rinv * g0[1] * siluf_(h2f_hi(zprev.x)));
            w.y = pk2(o0[2] * rinv * g0[2] * siluf_(h2f_lo(zprev.y)), o0[3] * rinv * g0[3] * siluf_(h2f_hi(zprev.y)));
            w.z = pk2(o1[0] * rinv * g1[0] * siluf_(h2f_lo(zprev.z)), o1[1] * rinv * g1[1] * siluf_(h2f_hi(zprev.z)));
            w.w = pk2(o1[2] * rinv * g1[2] * siluf_(h2f_lo(zprev.w)), o1[3] * rinv * g1[3] * siluf_(h2f_hi(zprev.w)));
            *(u32x4*)(y + (tok0 + (size_t)(n - 1) * 64 + t) * D + ycol + 8 * cg) = w;
        }
        if (n == NCHUNK) break;
        {
            const float la = -expA * softplusf_(bf2f(ga) + dtb), beta_l = sigmoidf_(bf2f(gb));
            float bcv = la;
#pragma unroll
            for (int off = 1; off < 64; off <<= 1) { const float u = __shfl_up(bcv, off); if (lane >= off) bcv += u; }
            const float bl = __shfl(bcv, 63);
            const float beta_t = __shfl(beta_l, t);
            if (wv == 0) { const float e = __expf(bcv); LDS_AT(float, V_BC + 4 * lane) = bcv; LDS_AT(float, V_EB + 4 * lane) = e; LDS_AT(float, V_CB + 4 * lane) = beta_l * e;
                LDS_AT(float, V_DB + 4 * lane) = __expf(bl - bcv); LDS_AT(float, V_BE + 4 * lane) = beta_l; if (lane == 0) LDS_AT(float, V_D) = __expf(bl); }
            float cv[3][8];
#pragma unroll
            for (int s = 0; s < 3; ++s) {
#pragma unroll
                for (int i = 0; i < 8; ++i) cv[s][i] = 0.f;
#pragma unroll
                for (int j = 0; j < 4; ++j) {
                    const f32x4 w0 = LDS_AT(f32x4, O_CW + (j * 192 + s * 64 + 8 * cg) * 4), w1 = LDS_AT(f32x4, O_CW + (j * 192 + s * 64 + 8 * cg + 4) * 4);
                    const u32x4 r = raw[s][j];
                    cv[s][0] += w0[0] * h2f_lo(r.x); cv[s][1] += w0[1] * h2f_hi(r.x); cv[s][2] += w0[2] * h2f_lo(r.y); cv[s][3] += w0[3] * h2f_hi(r.y);
                    cv[s][4] += w1[0] * h2f_lo(r.z); cv[s][5] += w1[1] * h2f_hi(r.z); cv[s][6] += w1[2] * h2f_lo(r.w); cv[s][7] += w1[3] * h2f_hi(r.w);
                }
#pragma unroll
                for (int i = 0; i < 8; ++i) cv[s][i] = siluf_(cv[s][i]);
            }
            float sq = 0.f, sk = 0.f;
#pragma unroll
            for (int i = 0; i < 8; ++i) { sq += cv[0][i] * cv[0][i]; sk += cv[1][i] * cv[1][i]; }
            sq += __shfl_xor(sq, 1); sq += __shfl_xor(sq, 2); sq += __shfl_xor(sq, 4);
            sk += __shfl_xor(sk, 1); sk += __shfl_xor(sk, 2); sk += __shfl_xor(sk, 4);
            const float nq = 0.125f / sqrtf(sq + NORM_EPS), nk = 1.0f / sqrtf(sk + NORM_EPS);
            u32x4 wq, wk;
            wq.x = pk2(cv[0][0] * nq, cv[0][1] * nq); wq.y = pk2(cv[0][2] * nq, cv[0][3] * nq); wq.z = pk2(cv[0][4] * nq, cv[0][5] * nq); wq.w = pk2(cv[0][6] * nq, cv[0][7] * nq);
            wk.x = pk2(cv[1][0] * nk, cv[1][1] * nk); wk.y = pk2(cv[1][2] * nk, cv[1][3] * nk); wk.z = pk2(cv[1][4] * nk, cv[1][5] * nk); wk.w = pk2(cv[1][6] * nk, cv[1][7] * nk);
            LDS_AT(u32x4, O_Q + t * (RS * 2) + 16 * cg) = wq;
            LDS_AT(u32x4, O_K + t * (RS * 2) + 16 * cg) = wk;
            const int pc = (t ^ (8 * cg)) * 2;
#pragma unroll
            for (int i = 0; i < 8; ++i) {
                LDS_AT(unsigned short, O_KT + (8 * cg + i) * (RS * 2) + pc) = (unsigned short)f2bf(cv[1][i] * nk);
                LDS_AT(unsigned short, O_VB + (8 * cg + i) * (RS * 2) + pc) = (unsigned short)f2bf(cv[2][i] * beta_t);
            }
            zprev = zraw;
        }
        if (n + 1 < NCHUNK) GDN_PREFETCH(n + 1);
        WG_BAR();
        {
            const int m = lane & 15, q = lane >> 4;
            if (wv < 4) {
                const int i = wv, r0 = 16 * i;
                const half8 kf0 = frag_std(L, O_K, r0 + m, 0, q, 0), kf1 = frag_std(L, O_K, r0 + m, 1, q, 0);
                const half8 qf0 = frag_std(L, O_Q, r0 + m, 0, q, 0), qf1 = frag_std(L, O_Q, r0 + m, 1, q, 0);
                f32x4 kk = mfma32h(kf0, kf0, (f32x4){0.f, 0.f, 0.f, 0.f}); kk = mfma32h(kf1, kf1, kk);
                f32x4 qk = mfma32h(kf0, qf0, (f32x4){0.f, 0.f, 0.f, 0.f}); qk = mfma32h(kf1, qf1, qk);
                const float bc_n = LDS_AT(float, V_BC + 4 * (r0 + m)), be_n = LDS_AT(float, V_BE + 4 * (r0 + m));
                const f32x4 bc_r = LDS_AT(f32x4, V_BC + 4 * (r0 + 4 * q)), be_r = LDS_AT(f32x4, V_BE + 4 * (r0 + 4 * q));
                f32x4 Lc, Ltc, Pc, Ptc, atv;
#pragma unroll
                for (int r = 0; r < 4; ++r) { const int rr = 4 * q + r;
                    const float e_rn = __expf(fminf(bc_r[r] - bc_n, 0.f)), e_nr = __expf(fminf(bc_n - bc_r[r], 0.f));
                    Lc[r] = (m < rr) ? be_r[r] * kk[r] * e_rn : 0.f;
                    Ltc[r] = (rr < m) ? be_n * kk[r] * e_nr : 0.f;
                    atv[r] = (rr <= m) ? qk[r] * e_nr : 0.f;
                    const float id = (rr == m) ? 1.f : 0.f; Pc[r] = id - Lc[r]; Ptc[r] = id - Ltc[r]; }
                const f32x4 Z = (f32x4){0.f, 0.f, 0.f, 0.f};
                const half4 hM = to_h4(Lc), hMt = to_h4(Ltc), hPt = to_h4(Ptc);
                const f32x4 M2 = mfma16h(hMt, hM, Z), M2t = mfma16h(hM, hMt, Z);
                const half4 hM2 = to_h4(M2), hM2t = to_h4(M2t);
                const f32x4 P2t = mfma16h(hM2, hPt, Ptc);
                const f32x4 M4 = mfma16h(hM2t, hM2, Z), M4t = mfma16h(hM2, hM2t, Z);
                const half4 hM4 = to_h4(M4), hM4t = to_h4(M4t), hP2t = to_h4(P2t);
                const f32x4 P3t = mfma16h(hM4, hP2t, P2t);
                const f32x4 M8 = mfma16h(hM4t, hM4, Z);
                const half4 hM8 = to_h4(M8), hP3t = to_h4(P3t);
                const f32x4 Dt = mfma16h(hM8, hP3t, P3t);
                (void)Pc;
                LDS_AT(half4, O_G + (r0 + m) * (RS * 2) + (r0 + 4 * q) * 2) = to_h4(Dt);
                LDS_AT(half4, O_AT + (r0 + m) * (RS * 2) + (r0 + 4 * q) * 2) = to_h4(atv);
            } else {
#pragma unroll
                for (int rep = 0; rep < 2; ++rep) {
                    int ti, tj;
                    if (rep == 0) { ti = wv == 4 ? 1 : wv == 7 ? 3 : 2; tj = wv == 6 ? 1 : 0; }
                    else { if (wv >= 6) break; ti = 3; tj = wv == 4 ? 1 : 2; }
                    const half8 kj0 = frag_std(L, O_K, 16 * tj + m, 0, q, 0), kj1 = frag_std(L, O_K, 16 * tj + m, 1, q, 0);
                    const half8 ki0 = frag_std(L, O_K, 16 * ti + m, 0, q, 0), ki1 = frag_std(L, O_K, 16 * ti + m, 1, q, 0);
                    const half8 qi0 = frag_std(L, O_Q, 16 * ti + m, 0, q, 0), qi1 = frag_std(L, O_Q, 16 * ti + m, 1, q, 0);
                    f32x4 kk = mfma32h(kj0, ki0, (f32x4){0.f, 0.f, 0.f, 0.f}); kk = mfma32h(kj1, ki1, kk);
                    f32x4 qk = mfma32h(kj0, qi0, (f32x4){0.f, 0.f, 0.f, 0.f}); qk = mfma32h(kj1, qi1, qk);
                    const float bc_t = LDS_AT(float, V_BC + 4 * (16 * ti + m)), be_t = LDS_AT(float, V_BE + 4 * (16 * ti + m));
                    const f32x4 bc_s = LDS_AT(f32x4, V_BC + 4 * (16 * tj + 4 * q));
                    f32x4 gv, av;
#pragma unroll
                    for (int r = 0; r < 4; ++r) { const float e = __expf(fminf(bc_t - bc_s[r], 0.f)); gv[r] = -be_t * kk[r] * e; av[r] = qk[r] * e; }
                    LDS_AT(half4, O_G + (16 * ti + m) * (RS * 2) + (16 * tj + 4 * q) * 2) = to_h4(gv);
                    LDS_AT(half4, O_AT + (16 * ti + m) * (RS * 2) + (16 * tj + 4 * q) * 2) = to_h4(av);
                }
            }
        }
        WG_BAR();
        if (wv < 4) {
            const int m = lane & 15, q = lane >> 4, c = wv;
            const f32x4 Z = (f32x4){0.f, 0.f, 0.f, 0.f};
            const half8 Sop0 = acc2op(S[0], S[1]), Sop1 = acc2op(S[2], S[3]);
            const int vrow = 16 * c + m, vsw = swz8(vrow);
            f32x4 rr[4];
#pragma unroll
            for (int rt = 0; rt < 4; ++rt) {
                f32x4 acc = mfma32h(frag_perm(L, O_K, 16 * rt + m, 0, q, 0), Sop0, Z); acc = mfma32h(frag_perm(L, O_K, 16 * rt + m, 1, q, 0), Sop1, acc);
                const half4 vb = LDS_AT(half4, O_VB + vrow * (RS * 2) + (((16 * rt + 4 * q) ^ vsw) * 2));
                const f32x4 cb = LDS_AT(f32x4, V_CB + 4 * (16 * rt + 4 * q));
#pragma unroll
                for (int r = 0; r < 4; ++r) rr[rt][r] = (float)vb[r] - cb[r] * acc[r];
            }
            const half8 g00 = frag_perm(L, O_G, 0 + m, 0, q, 0), g10 = frag_perm(L, O_G, 16 + m, 0, q, 0), g20 = frag_perm(L, O_G, 32 + m, 0, q, 0), g21 = frag_perm(L, O_G, 32 + m, 1, q, 0),
                        g30 = frag_perm(L, O_G, 48 + m, 0, q, 0), g31 = frag_perm(L, O_G, 48 + m, 1, q, 0);
            const f32x4 v0 = mfma32h(g00, acc2op(rr[0], Z), Z);
            const f32x4 a1 = mfma32h(g10, acc2op(v0, Z), rr[1]);
            const f32x4 v1 = mfma32h(g10, acc2op(Z, a1), Z);
            const half8 v01 = acc2op(v0, v1);
            const f32x4 a2 = mfma32h(g20, v01, rr[2]);
            const f32x4 v2 = mfma32h(g21, acc2op(a2, Z), Z);
            f32x4 a3 = mfma32h(g30, v01, rr[3]); a3 = mfma32h(g31, acc2op(v2, Z), a3);
            const f32x4 v3 = mfma32h(g31, acc2op(Z, a3), Z);
            const half8 v23 = acc2op(v2, v3);
#pragma unroll
            for (int rt = 0; rt < 4; ++rt) {
                f32x4 acc = mfma32h(frag_perm(L, O_Q, 16 * rt + m, 0, q, 0), Sop0, Z); acc = mfma32h(frag_perm(L, O_Q, 16 * rt + m, 1, q, 0), Sop1, acc);
                const f32x4 eb = LDS_AT(f32x4, V_EB + 4 * (16 * rt + 4 * q));
                acc = acc * eb;
                acc = mfma32h(frag_perm(L, O_AT, 16 * rt + m, 0, q, 0), v01, acc);
                if (rt >= 2) acc = mfma32h(frag_perm(L, O_AT, 16 * rt + m, 1, q, 0), v23, acc);
#pragma unroll
                for (int r = 0; r < 4; ++r) LDS_AT(float, O_OB + ((16 * rt + 4 * q + r) * OBS + 16 * c + m) * 4) = acc[r];
            }
            const f32x4 db0 = LDS_AT(f32x4, V_DB + 4 * (4 * q)), db1 = LDS_AT(f32x4, V_DB + 4 * (16 + 4 * q)), db2 = LDS_AT(f32x4, V_DB + 4 * (32 + 4 * q)), db3 = LDS_AT(f32x4, V_DB + 4 * (48 + 4 * q));
            const half8 w01 = acc2op(v0 * db0, v1 * db1), w23 = acc2op(v2 * db2, v3 * db3);
            const float dsc = LDS_AT(float, V_D);
#pragma unroll
            for (int rt = 0; rt < 4; ++rt) { const int krow = 16 * rt + m, ksw = swz8(krow);
                f32x4 acc = S[rt] * dsc;
                acc = mfma32h(frag_perm(L, O_KT, krow, 0, q, ksw), w01, acc); acc = mfma32h(frag_perm(L, O_KT, krow, 1, q, ksw), w23, acc);
                S[rt] = acc; }
        }
        WG_BAR();
    }
#undef GDN_PREFETCH
}

__device__ __forceinline__ unsigned pk2b(float lo, float hi) { unsigned r; asm volatile("v_cvt_pk_bf16_f32 %0, %1, %2" : "=v"(r) : "v"(lo), "v"(hi)); return r; }
__device__ __forceinline__ f32x4 mfma32b(bfr8 a, bfr8 b, f32x4 c) { return __builtin_amdgcn_mfma_f32_16x16x32_bf16(a, b, c, 0, 0, 0); }
template <int DK, int DV, bool ISA>
__device__ __forceinline__ void mix_gla_fast(const Args& a, int layer, int b, int h, LAS unsigned char* L) {
    constexpr int O_QS = 0, O_KV = TILEB, O_P = O_KV + 160 * RS * 2, O_QT = O_P + TILEB, O_KST = O_QT + TILEB, O_VT = O_KST + TILEB, O_OB = O_VT + DV * RS * 2, OBS = DV + 4;
    constexpr int V_DS = O_OB + 64 * OBS * 4, LDS_END = V_DS + 256;
    static_assert(LDS_END <= LDS_BYTES, "GLA LDS map");
    constexpr int NGW = DK / 8;
    constexpr int NG2 = DV / 8 - 8;
    int tid0 = threadIdx.x; asm volatile("" : "+v"(tid0));
    const bf16* proj = (const bf16*)(a.ws + WS_PROJ);
    bf16* y = (bf16*)(a.ws + WS_HY);
    const int base = ISA ? A_BASE + 256 * h : B_BASE + 288 * h;
    const int vcol = ISA ? base + 128 : base + 96, zcol = base + 192, ycol = ISA ? 64 * h : 256 + 96 * h;
    const float* gain = ISA ? a.in[I_GA] + layer * 64 : a.in[I_GB] + layer * 96;
    const float* lb = (const float*)(a.ws + WS_LB) + layer * 256 + h * 64;
    const float* wgk = a.in[I_WGK] + (size_t)layer * 16 * 192 + h * 48;
    const float* bgk = a.in[I_BGK] + layer * 192 + h * 48;
    for (int i = tid0; i < O_OB / 16; i += NTHREADS) LDS_AT(u32x4, 16 * i) = (u32x4){0u, 0u, 0u, 0u};
    if (tid0 < 64) LDS_AT(float, V_DS + 4 * tid0) = 1.f;
    f32x4 S[4];
#pragma unroll
    for (int i = 0; i < 4; ++i) S[i] = (f32x4){0.f, 0.f, 0.f, 0.f};
    const u32x4 Z4 = (u32x4){0u, 0u, 0u, 0u};
    u32x4 qraw = Z4, fraw = Z4, lr0 = Z4, lr1 = Z4, vraw = Z4, vraw2 = Z4, zraw = Z4, zraw2 = Z4, zprev = Z4, zprev2 = Z4;
    const size_t tok0 = (size_t)b * SEQ;
#define GLA_PREFETCH(n_) do { const int w_ = tid0 >> 6, ln_ = tid0 & 63, tv_ = tid0 >> 3, pt_ = tid0 & 7; \
        if (w_ < NGW) { const bf16* row_ = proj + (tok0 + (n_) * 64 + ln_) * NP; qraw = *(const u32x4*)(row_ + base + 8 * w_); fraw = *(const u32x4*)(row_ + base + (ISA ? 64 : 48) + 8 * w_); \
            if (!ISA) { lr0 = *(const u32x4*)(row_ + LR_COL); lr1 = *(const u32x4*)(row_ + LR_COL + 8); } } \
        { const bf16* row_ = proj + (tok0 + (n_) * 64 + tv_) * NP; vraw = *(const u32x4*)(row_ + vcol + 8 * pt_); zraw = *(const u32x4*)(row_ + zcol + 8 * pt_); \
            if (NG2 > 0 && pt_ < NG2) { vraw2 = *(const u32x4*)(row_ + vcol + 64 + 8 * pt_); zraw2 = *(const u32x4*)(row_ + zcol + 64 + 8 * pt_); } } } while (0)
    GLA_PREFETCH(0);
    WG_BAR();
#pragma unroll 1
    for (int n = 0; n <= NCHUNK; ++n) {
        int tid = tid0; asm volatile("" : "+v"(tid));
        const int lane = tid & 63, wv = __builtin_amdgcn_readfirstlane(tid >> 6), tv = tid >> 3, pt = tid & 7;
        if (n > 0) {
            const f32x4 o0 = LDS_AT(f32x4, O_OB + (tv * OBS + 8 * pt) * 4), o1 = LDS_AT(f32x4, O_OB + (tv * OBS + 8 * pt + 4) * 4);
            f32x4 o2 = (f32x4){0.f, 0.f, 0.f, 0.f}, o3 = o2;
            if (NG2 > 0 && pt < NG2) { o2 = LDS_AT(f32x4, O_OB + (tv * OBS + 64 + 8 * pt) * 4); o3 = LDS_AT(f32x4, O_OB + (tv * OBS + 64 + 8 * pt + 4) * 4); }
            float s2 = (o0[0] * o0[0] + o0[1] * o0[1]) + (o0[2] * o0[2] + o0[3] * o0[3]) + (o1[0] * o1[0] + o1[1] * o1[1]) + (o1[2] * o1[2] + o1[3] * o1[3]);
            s2 += (o2[0] * o2[0] + o2[1] * o2[1]) + (o2[2] * o2[2] + o2[3] * o2[3]) + (o3[0] * o3[0] + o3[1] * o3[1]) + (o3[2] * o3[2] + o3[3] * o3[3]);
            s2 += __shfl_xor(s2, 1); s2 += __shfl_xor(s2, 2); s2 += __shfl_xor(s2, 4);
            const float rinv = 1.0f / sqrtf(s2 * (1.0f / DV) + NORM_EPS);
            bf16* yrow = y + (tok0 + (size_t)(n - 1) * 64 + tv) * D + ycol;
            { const f32x4 g0 = *(const f32x4*)(gain + 8 * pt), g1 = *(const f32x4*)(gain + 8 * pt + 4); u32x4 w;
              w.x = pk2(o0[0] * rinv * g0[0] * siluf_(h2f_lo(zprev.x)), o0[1] * rinv * g0[1] * siluf_(h2f_hi(zprev.x)));
              w.y = pk2(o0[2] * rinv * g0[2] * siluf_(h2f_lo(zprev.y)), o0[3] * rinv * g0[3] * siluf_(h2f_hi(zprev.y)));
              w.z = pk2(o1[0] * rinv * g1[0] * siluf_(h2f_lo(zprev.z)), o1[1] * rinv * g1[1] * siluf_(h2f_hi(zprev.z)));
              w.w = pk2(o1[2] * rinv * g1[2] * siluf_(h2f_lo(zprev.w)), o1[3] * rinv * g1[3] * siluf_(h2f_hi(zprev.w)));
              *(u32x4*)(yrow + 8 * pt) = w; }
            if (NG2 > 0 && pt < NG2) { const f32x4 g0 = *(const f32x4*)(gain + 64 + 8 * pt), g1 = *(const f32x4*)(gain + 64 + 8 * pt + 4); u32x4 w;
              w.x = pk2(o2[0] * rinv * g0[0] * siluf_(h2f_lo(zprev2.x)), o2[1] * rinv * g0[1] * siluf_(h2f_hi(zprev2.x)));
              w.y = pk2(o2[2] * rinv * g0[2] * siluf_(h2f_lo(zprev2.y)), o2[3] * rinv * g0[3] * siluf_(h2f_hi(zprev2.y)));
              w.z = pk2(o3[0] * rinv * g1[0] * siluf_(h2f_lo(zprev2.z)), o3[1] * rinv * g1[1] * siluf_(h2f_hi(zprev2.z)));
              w.w = pk2(o3[2] * rinv * g1[2] * siluf_(h2f_lo(zprev2.w)), o3[3] * rinv * g1[3] * siluf_(h2f_hi(zprev2.w)));
              *(u32x4*)(yrow + 64 + 8 * pt) = w; }
        }
        if (n == NCHUNK) break;
        if (wv < NGW) {
            float qv[8], kv[8], bc[8];
            const unsigned qw[4] = {qraw.x, qraw.y, qraw.z, qraw.w}, fw[4] = {fraw.x, fraw.y, fraw.z, fraw.w};
            if (ISA) {
#pragma unroll
                for (int i = 0; i < 8; ++i) { const float qr = (i & 1) ? h2f_hi(qw[i >> 1]) : h2f_lo(qw[i >> 1]), fl = (i & 1) ? h2f_hi(fw[i >> 1]) : h2f_lo(fw[i >> 1]);
                    const float lbv = lb[8 * wv + i], e = __expf(-fmaxf(fl, -30.f)), sg = 1.0f / (1.0f + e);
                    qv[i] = siluf_(qr); kv[i] = (1.f - lbv) * (e * sg); bc[i] = __logf(fmaxf(lbv + (1.f - lbv) * sg, 1e-30f)); }
            } else {
                float lrv[16];
                const unsigned lw[8] = {lr0.x, lr0.y, lr0.z, lr0.w, lr1.x, lr1.y, lr1.z, lr1.w};
#pragma unroll
                for (int r = 0; r < 16; ++r) lrv[r] = (r & 1) ? h2f_hi(lw[r >> 1]) : h2f_lo(lw[r >> 1]);
#pragma unroll
                for (int i = 0; i < 8; ++i) { float s = bgk[8 * wv + i];
#pragma unroll
                    for (int r = 0; r < 16; ++r) s += lrv[r] * wgk[r * 192 + 8 * wv + i];
                    qv[i] = ((i & 1) ? h2f_hi(qw[i >> 1]) : h2f_lo(qw[i >> 1])) * 0.14433756729740643f; kv[i] = (i & 1) ? h2f_hi(fw[i >> 1]) : h2f_lo(fw[i >> 1]);
                    bc[i] = logsigmoidf_(s) * (1.0f / 16.0f); }
            }
#pragma unroll
            for (int off = 1; off < 64; off <<= 1) {
#pragma unroll
                for (int i = 0; i < 8; ++i) { const float u = __shfl_up(bc[i], off); if (lane >= off) bc[i] += u; } }
            const int it = lane >> 4;
            float qs[8], qt[8], k0[8], k1[8], k2[8], k3[8], kst[8];
#pragma unroll
            for (int i = 0; i < 8; ++i) {
                const float B1 = __shfl(bc[i], 15), B2 = __shfl(bc[i], 31), B3 = __shfl(bc[i], 47), bl = __shfl(bc[i], 63);
                const float Bown = it == 0 ? 0.f : it == 1 ? B1 : it == 2 ? B2 : B3;
                qs[i] = qv[i] * __expf(bc[i] - Bown); qt[i] = qv[i] * __expf(bc[i]);
                k0[i] = kv[i] * __expf(fminf(-bc[i], 60.f)); k1[i] = kv[i] * __expf(fminf(B1 - bc[i], 60.f)); k2[i] = kv[i] * __expf(fminf(B2 - bc[i], 60.f)); k3[i] = kv[i] * __expf(fminf(B3 - bc[i], 60.f));
                kst[i] = kv[i] * __expf(bl - bc[i]);
                if (lane == 0) LDS_AT(float, V_DS + 4 * (8 * wv + i)) = __expf(bl);
            }
            u32x4 w;
            w.x = pk2b(qs[0], qs[1]); w.y = pk2b(qs[2], qs[3]); w.z = pk2b(qs[4], qs[5]); w.w = pk2b(qs[6], qs[7]); LDS_AT(u32x4, O_QS + lane * (RS * 2) + 16 * wv) = w;
            w.x = pk2(qt[0], qt[1]); w.y = pk2(qt[2], qt[3]); w.z = pk2(qt[4], qt[5]); w.w = pk2(qt[6], qt[7]); LDS_AT(u32x4, O_QT + lane * (RS * 2) + 16 * wv) = w;
            if (it == 0) { w.x = pk2b(k0[0], k0[1]); w.y = pk2b(k0[2], k0[3]); w.z = pk2b(k0[4], k0[5]); w.w = pk2b(k0[6], k0[7]); LDS_AT(u32x4, O_KV + (0 + lane) * (RS * 2) + 16 * wv) = w; }
            if (it <= 1) { w.x = pk2b(k1[0], k1[1]); w.y = pk2b(k1[2], k1[3]); w.z = pk2b(k1[4], k1[5]); w.w = pk2b(k1[6], k1[7]); LDS_AT(u32x4, O_KV + (16 + lane) * (RS * 2) + 16 * wv) = w; }
            if (it <= 2) { w.x = pk2b(k2[0], k2[1]); w.y = pk2b(k2[2], k2[3]); w.z = pk2b(k2[4], k2[5]); w.w = pk2b(k2[6], k2[7]); LDS_AT(u32x4, O_KV + (48 + lane) * (RS * 2) + 16 * wv) = w; }
            { w.x = pk2b(k3[0], k3[1]); w.y = pk2b(k3[2], k3[3]); w.z = pk2b(k3[4], k3[5]); w.w = pk2b(k3[6], k3[7]); LDS_AT(u32x4, O_KV + (96 + lane) * (RS * 2) + 16 * wv) = w; }
            const int pc = (lane ^ (8 * wv)) * 2;
#pragma unroll
            for (int i = 0; i < 8; ++i) LDS_AT(unsigned short, O_KST + (8 * wv + i) * (RS * 2) + pc) = (unsigned short)f2bf(kst[i]);
        }
        {
            const unsigned vw[4] = {vraw.x, vraw.y, vraw.z, vraw.w};
            const int pc = (tv ^ (8 * pt)) * 2;
#pragma unroll
            for (int i = 0; i < 8; ++i) LDS_AT(unsigned short, O_VT + (8 * pt + i) * (RS * 2) + pc) = (unsigned short)((i & 1) ? (vw[i >> 1] >> 16) : (vw[i >> 1] & 0xffffu));
            if (NG2 > 0 && pt < NG2) { const unsigned vw2[4] = {vraw2.x, vraw2.y, vraw2.z, vraw2.w};
#pragma unroll
                for (int i = 0; i < 8; ++i) LDS_AT(unsigned short, O_VT + (64 + 8 * pt + i) * (RS * 2) + pc) = (unsigned short)((i & 1) ? (vw2[i >> 1] >> 16) : (vw2[i >> 1] & 0xffffu)); }
            zprev = zraw; zprev2 = zraw2;
        }
        if (n + 1 < NCHUNK) GLA_PREFETCH(n + 1);
        WG_BAR();
        {
            const int m = lane & 15, q = lane >> 4;
#pragma unroll
            for (int rep = 0; rep < 2; ++rep) {
                const int tix = wv + 8 * rep; if (tix >= 10) break;
                const int ti = tix == 0 ? 0 : tix <= 2 ? 1 : tix <= 5 ? 2 : 3, tj = tix - (ti * (ti + 1)) / 2;
                const int kvbase = ti == 0 ? 0 : ti == 1 ? 16 : ti == 2 ? 48 : 96;
                const bfr8 a0 = LDS_AT(bfr8, O_KV + (kvbase + 16 * tj + m) * (RS * 2) + (8 * q) * 2), a1 = LDS_AT(bfr8, O_KV + (kvbase + 16 * tj + m) * (RS * 2) + (32 + 8 * q) * 2);
                const bfr8 b0 = LDS_AT(bfr8, O_QS + (16 * ti + m) * (RS * 2) + (8 * q) * 2), b1 = LDS_AT(bfr8, O_QS + (16 * ti + m) * (RS * 2) + (32 + 8 * q) * 2);
                f32x4 p = mfma32b(a0, b0, (f32x4){0.f, 0.f, 0.f, 0.f}); p = mfma32b(a1, b1, p);
                if (ti == tj) {
#pragma unroll
                    for (int r = 0; r < 4; ++r) if (4 * q + r > m) p[r] = 0.f; }
                LDS_AT(half4, O_P + (16 * ti + m) * (RS * 2) + (16 * tj + 4 * q) * 2) = to_h4(p);
            }
        }
        WG_BAR();
        if (wv < DV / 16) {
            const int m = lane & 15, q = lane >> 4, c = wv;
            const f32x4 Z = (f32x4){0.f, 0.f, 0.f, 0.f};
            const half8 Sop0 = acc2op(S[0], S[1]), Sop1 = acc2op(S[2], S[3]);
            const int vrow = 16 * c + m, vsw = swz8(vrow);
            const half8 vf0 = frag_std(L, O_VT, vrow, 0, q, vsw), vf1 = frag_std(L, O_VT, vrow, 1, q, vsw);
#pragma unroll
            for (int rt = 0; rt < 4; ++rt) {
                f32x4 acc = mfma32h(frag_std(L, O_P, 16 * rt + m, 0, q, 0), vf0, Z);
                if (rt >= 2) acc = mfma32h(frag_std(L, O_P, 16 * rt + m, 1, q, 0), vf1, acc);
                acc = mfma32h(frag_perm(L, O_QT, 16 * rt + m, 0, q, 0), Sop0, acc); acc = mfma32h(frag_perm(L, O_QT, 16 * rt + m, 1, q, 0), Sop1, acc);
#pragma unroll
                for (int r = 0; r < 4; ++r) LDS_AT(float, O_OB + ((16 * rt + 4 * q + r) * OBS + 16 * c + m) * 4) = acc[r];
            }
#pragma unroll
            for (int rt = 0; rt < 4; ++rt) { const int krow = 16 * rt + m, ksw = swz8(krow);
                const f32x4 ds = LDS_AT(f32x4, V_DS + 4 * (16 * rt + 4 * q));
                f32x4 acc = S[rt] * ds;
                acc = mfma32h(frag_std(L, O_KST, krow, 0, q, ksw), vf0, acc); acc = mfma32h(frag_std(L, O_KST, krow, 1, q, ksw), vf1, acc);
                S[rt] = acc; }
        }
        WG_BAR();
    }
#undef GLA_PREFETCH
}
#ifndef FAST_A
#define FAST_A 0
#endif
#ifndef FAST_B
#define FAST_B 0
#endif
#ifndef FAST_C
#define FAST_C 0
#endif
__device__ __forceinline__ void p3_mixers(const Args& a, int layer, unsigned char* lds_g) {
    const int id = blockIdx.x;
    if (id < 96) {
#if FAST_C
        mix_gdn_fast(a, layer, id / 6, id % 6, (LAS unsigned char*)lds_g);
#else
        mix_gdn_base(a, layer, id / 6, id % 6, (float*)lds_g);
#endif
    } else if (id < 160) {
#if FAST_A
        mix_gla_fast<64, 64, true>(a, layer, (id - 96) >> 2, (id - 96) & 3, (LAS unsigned char*)lds_g);
#else
        mix_gla_base<64, 64, true>(a, layer, (id - 96) >> 2, (id - 96) & 3, (float*)lds_g);
#endif
    } else if (id < 224) {
#if FAST_B
        mix_gla_fast<48, 96, false>(a, layer, (id - 160) >> 2, (id - 160) & 3, (LAS unsigned char*)lds_g);
#else
        mix_gla_base<48, 96, false>(a, layer, (id - 160) >> 2, (id - 160) & 3, (float*)lds_g);
#endif
    }
}
#ifndef MK_ONE_LAUNCH
#define MK_ONE_LAUNCH 0
#endif
constexpr int N_PHASES = 10;
template <int PLO, int PHI> __global__ void __launch_bounds__(NTHREADS, 2) mega(Args args_) {
    extern __shared__ __attribute__((aligned(16))) unsigned char lds[];
#if defined(__HIP_DEVICE_COMPILE__)
#define ARGS() const Args args = *({ const __attribute__((address_space(4))) Args* ap_ = (const __attribute__((address_space(4))) Args*)__builtin_amdgcn_kernarg_segment_ptr(); asm volatile("" : "+s"(ap_)); ap_; })
#else
#define ARGS() const Args args = args_
#endif
    constexpr int lo = PLO, hi = PHI;
#define IN(k) (lo <= (k) && (k) < hi)
#define SEAM(k) do { if (IN(k) && IN((k) + 1)) { cg::this_grid().sync(); } } while (0)
#define WSP(T, off) ((T*)(args.ws + (off)))
    if (IN(0)) { ARGS(); p0_prep(args, lds); }
    SEAM(0);
    if (IN(1)) { ARGS(); ln_rows<0>(args.in[I_X], nullptr, WSP(bf16, WS_HY), nullptr, nullptr, WSP(float, WS_MOD)); }
    SEAM(1);
#pragma unroll
    for (int l = 0; l < 2; ++l) {
        const int p = 2 + 4 * l;
        if (IN(p)) { ARGS();
            pg8::Gemm g{WSP(bf16, WS_HY), WSP(bf16, WS_WIN) + (size_t)l * NP * 1024, M, NP, D}; pg8::StaticOrder S; S.init(M, NP, gridDim.x, (int)blockIdx.x);
            pg8::EpiBf16<0> E{WSP(bf16, WS_PROJ), NP, nullptr, 0, 0, 1.f};
            pg8::gemm_phase<pg8::EpiBf16<0>, pg8::StaticOrder, true, true>((PG8_LAS unsigned char*)lds, g, S, E);
        }
        SEAM(p);
        if (IN(p + 1)) { ARGS(); p3_mixers(args, l, lds); }
        SEAM(p + 1);
        if (IN(p + 2)) { ARGS();
            const float* xin = l == 0 ? args.in[I_X] : WSP(float, WS_X1);
            pg8::Gemm g{WSP(bf16, WS_HY), WSP(bf16, WS_WOUT) + (size_t)l * 1024 * 1024, M, D, D}; pg8::StaticOrder S; S.init(M, D, gridDim.x, (int)blockIdx.x);
            EpiRes E{xin, args.out, WSP(float, WS_MOD) + (size_t)l * 16 * 3072 + 2048};
            pg8::gemm_phase<EpiRes, pg8::StaticOrder, true, true>((PG8_LAS unsigned char*)lds, g, S, E);
        }
        SEAM(p + 2);
        if (IN(p + 3)) { ARGS();
            if (l == 0) ln_rows<1>(args.out, WSP(float, WS_X1), WSP(bf16, WS_HY), args.in[I_LNG], args.in[I_LNB], WSP(float, WS_MOD) + (size_t)16 * 3072);
            else ln_rows<1>(args.out, args.out, nullptr, args.in[I_LNG] + 1024, args.in[I_LNB] + 1024, nullptr);
        }
        if (l == 0) SEAM(p + 3);
    }
#undef WSP
#undef ARGS
#undef IN
#undef SEAM
}

#include <utility>
template <int P> static hipError_t set_attr1() { return hipFuncSetAttribute((const void*)mega<P, P + 1>, hipFuncAttributeMaxDynamicSharedMemorySize, LDS_BYTES); }
template <int... P> static hipError_t set_attrs_(std::integer_sequence<int, P...>) { hipError_t e = hipSuccess; hipError_t r[] = {set_attr1<P>()...}; for (hipError_t x : r) if (x != hipSuccess) e = x; return e; }
static hipError_t set_attrs() {
#if MK_ONE_LAUNCH
    return hipFuncSetAttribute((const void*)mega<0, N_PHASES>, hipFuncAttributeMaxDynamicSharedMemorySize, LDS_BYTES);
#else
    return set_attrs_(std::make_integer_sequence<int, N_PHASES>{});
#endif
}
template <int P> static int launch1(const Args& a, int grid, hipStream_t stream) { hipLaunchKernelGGL((mega<P, P + 1>), dim3(grid), dim3(NTHREADS), LDS_BYTES, stream, a); return 0; }
template <int... P> static void launch_all(const Args& a, int grid, hipStream_t stream, std::integer_sequence<int, P...>) { int r[] = {launch1<P>(a, grid, stream)...}; (void)r; }
extern "C" void kernel_launch(void* const* d_in, const int* in_sizes, int n_in, void* d_out, int out_size, void* d_ws, size_t ws_size, hipStream_t stream) {
    static int grid = 0;
    if (grid == 0) {
        if (n_in != 17 || out_size != M * D || ws_size < WS_END) { fprintf(stderr, "kernel_launch: unexpected shapes (n_in %d out %d ws %zu)\n", n_in, out_size, ws_size); grid = -1; return; }
        if (set_attrs() != hipSuccess) { fprintf(stderr, "kernel_launch: hipFuncSetAttribute failed\n"); grid = -1; return; }
        int dev = 0, cus = 0, per_cu = 0;
        (void)hipGetDevice(&dev); (void)hipDeviceGetAttribute(&cus, hipDeviceAttributeMultiprocessorCount, dev);
#if MK_ONE_LAUNCH
        (void)hipOccupancyMaxActiveBlocksPerMultiprocessor(&per_cu, (const void*)mega<0, N_PHASES>, NTHREADS, LDS_BYTES);
#else
        per_cu = 1;
#endif
        if (per_cu < 1 || cus < 256) { fprintf(stderr, "kernel_launch: occupancy %d blocks/CU, %d CUs: cannot run\n", per_cu, cus); grid = -1; return; }
        grid = 256;
    }
    if (grid < 0) return;
    Args a{};
    for (int i = 0; i < 17; ++i) a.in[i] = (const float*)d_in[i];
    a.out = (float*)d_out; a.ws = (unsigned char*)d_ws;
#if MK_ONE_LAUNCH
    a.ph_lo = 0; a.ph_hi = N_PHASES;
    void* kargs[] = {&a};
    hipError_t e = hipLaunchCooperativeKernel((const void*)mega<0, N_PHASES>, dim3(grid), dim3(NTHREADS), kargs, LDS_BYTES, stream);
    if (e != hipSuccess) fprintf(stderr, "kernel_launch: cooperative launch failed: %s\n", hipGetErrorString(e));
#else
    launch_all(a, grid, stream, std::make_integer_sequence<int, N_PHASES>{});
#endif
}
```

```cpp
#include <hip/hip_runtime.h>
#include <hip/hip_cooperative_groups.h>
#include <cstdio>
#include <cstdint>
namespace cg = cooperative_groups;
#define MK_ONE_LAUNCH 1
#define FAST_C 1
#define FAST_A 1
#define FAST_B 1
namespace pg8 {
#define PG8_LAS __attribute__((address_space(3)))
typedef unsigned short bf16_t;
typedef short bf16x8 __attribute__((ext_vector_type(8)));
typedef _Float16 half8 __attribute__((ext_vector_type(8)));
typedef float f32x4 __attribute__((ext_vector_type(4)));
typedef unsigned u32x4 __attribute__((ext_vector_type(4)));
constexpr int BM = 256, BK = 64, HALF = 128, HTB = HALF * BK * 2  , STAGE_BYTES = 8 * HTB, NXCD = 8, WGM = 8;

__host__ __device__ __forceinline__ int lds_byte(int r, int c) { const int st = (r >> 4) * 2 + (c >> 5), rr = r & 15, cc = c & 31, ob = rr * 64 + cc * 2; return st * 1024 + (ob ^ (((ob >> 9) & 1) << 5)); }
__host__ __device__ __forceinline__ void stage_rc(int b, int& R, int& C) { const int st = b / 1024, sb = b % 1024, swz = sb ^ (((sb >> 9) & 1) << 5); R = (st >> 1) * 16 + swz / 64; C = (st & 1) * 32 + (swz % 64) / 2; }
__host__ __device__ __forceinline__ int perm32(int rho) { const int n = rho >> 4, i = rho & 15; return 8 * (i >> 2) + 4 * n + (i & 3); }

struct Unit { int pm, pn; };
struct Gemm { const bf16_t* A; const bf16_t* Bt; int M, N, K; };

struct StaticOrder {
    int nM, nN, nwg, G, c;
    __host__ __device__ void init(int M, int N, int G_, int c_) { nM = M / BM; nN = N / BM; nwg = nM * nN; G = G_; c = c_; }
    __host__ __device__ bool next(int i, Unit& u) const {
        const long L = (long)i * G + c; if (L >= nwg) return false;
        int wgid = (int)L; { const int q = nwg / NXCD, r = nwg % NXCD, xcd = wgid % NXCD, off = wgid / NXCD; wgid = (xcd < r ? xcd * (q + 1) : r * (q + 1) + (xcd - r) * q) + off; }
        const int nig = WGM * nN, gid = wgid / nig, fm = gid * WGM, gsz = (nM - fm) < WGM ? (nM - fm) : WGM;
        u.pm = fm + ((wgid % nig) % gsz); u.pn = (wgid % nig) / gsz; return true;
    }
    __device__ __forceinline__ void a_ready(const Unit&) const {}
    __device__ __forceinline__ void done(const Unit&) const {}
};

__device__ __forceinline__ unsigned cvt_pk_bf16(float lo, float hi) { unsigned r; asm volatile("v_cvt_pk_f16_f32 %0, %1, %2" : "=v"(r) : "v"(lo), "v"(hi)); return r; }
typedef float f32x2 __attribute__((ext_vector_type(2)));
__device__ __forceinline__ f32x2 gelu_pk(f32x2 v) {
    const f32x2 av = __builtin_elementwise_abs(v), d = av * 0.2316418882f + 1.0f;
    f32x2 t; t.x = __builtin_amdgcn_rcpf(d.x); t.y = __builtin_amdgcn_rcpf(d.y);
    f32x2 q = t * 0.5307027145f + (-0.7265760135f); q = q * t + 0.7107068705f; q = q * t + (-0.142248368f); q = q * t + 0.127414796f; q = q * t;
    const f32x2 s = (v * v) * (-0.72134752044f);
    f32x2 e; e.x = __builtin_amdgcn_exp2f(s.x); e.y = __builtin_amdgcn_exp2f(s.y);
    const f32x2 m = v * (q * e), r = v - m;
    f32x2 o; o.x = v.x < 0.f ? m.x : r.x; o.y = v.y < 0.f ? m.y : r.y; return o;
}

template <int ACT  > struct EpiBf16 {
    static constexpr bool PERM = true, AFTER_DRAIN = false; static_assert(ACT == 0 || ACT == 1, "EpiBf16: ACT is 0 (none) or 1 (gelu_pk)");
    bf16_t* O; int ldc; const float* bias; int split_cols; size_t split_stride; float scale0;
    __device__ __forceinline__ void operator()(const f32x4 (&acc)[2][2][4][2], const Unit& u, int wr, int wc, int fr, int fq) const {
        const int row0 = u.pm * BM + wr * 64 + fr; int colt = u.pn * BM; bf16_t* base = O;
        float sc = 1.f; if (split_cols) { const int t = colt / split_cols; base += (size_t)t * split_stride; colt -= t * split_cols; if (t == 0) sc = scale0; }
        const int col0 = colt + wc * 32 + 8 * fq, bcol0 = u.pn * BM + wc * 32 + 8 * fq;
        f32x4 bv[2][2];
#pragma unroll
        for (int bj = 0; bj < 2; ++bj)
#pragma unroll
            for (int n = 0; n < 2; ++n) bv[bj][n] = bias ? *(const f32x4*)(bias + bcol0 + bj * HALF + 4 * n) : (f32x4){0.f, 0.f, 0.f, 0.f};
#pragma unroll
        for (int ai = 0; ai < 2; ++ai)
#pragma unroll
            for (int m = 0; m < 4; ++m) { bf16_t* rowp = base + (size_t)(row0 + ai * HALF + m * 16) * ldc + col0;
#pragma unroll
                for (int bj = 0; bj < 2; ++bj) { f32x4 v0 = acc[ai][bj][m][0] + bv[bj][0], v1 = acc[ai][bj][m][1] + bv[bj][1];
                    if (ACT == 1) { f32x2 a = gelu_pk((f32x2){v0[0], v0[1]}), b = gelu_pk((f32x2){v0[2], v0[3]}), c = gelu_pk((f32x2){v1[0], v1[1]}), d = gelu_pk((f32x2){v1[2], v1[3]});
                        v0 = (f32x4){a.x, a.y, b.x, b.y}; v1 = (f32x4){c.x, c.y, d.x, d.y}; }
                    v0 = v0 * sc; v1 = v1 * sc; u32x4 w; w.x = cvt_pk_bf16(v0[0], v0[1]); w.y = cvt_pk_bf16(v0[2], v0[3]); w.z = cvt_pk_bf16(v1[0], v1[1]); w.w = cvt_pk_bf16(v1[2], v1[3]);
                    *(u32x4*)(rowp + bj * HALF) = w; } }
    }
};

struct PanelStats {
    unsigned* xbuf;
    unsigned* cnt;
    unsigned* tmo;
    int ntn; float eps;
    unsigned code;
    __device__ __forceinline__ bool run(const f32x4 (&v)[2][2][4][2], const Unit& u, int wr, int wc, int fr, int fq, PG8_LAS unsigned char* lds, int wid, int lane) const {
        typedef float f32x2v __attribute__((ext_vector_type(2)));
        PG8_LAS f32x2v* P = (PG8_LAS f32x2v*)lds;
        PG8_LAS f32x2v* S = (PG8_LAS f32x2v*)(lds + 8192);
        PG8_LAS unsigned* flag = (PG8_LAS unsigned*)(lds + 8192 + 2048);
#pragma unroll
        for (int ai = 0; ai < 2; ++ai)
#pragma unroll
            for (int m = 0; m < 4; ++m) {
                float s = 0.f;
#pragma unroll
                for (int bj = 0; bj < 2; ++bj)
#pragma unroll
                    for (int n = 0; n < 2; ++n) { const f32x4 x = v[ai][bj][m][n]; s += (x[0] + x[1]) + (x[2] + x[3]); }
                s += __shfl_xor(s, 16); s += __shfl_xor(s, 32);
                const float mw = s * (1.0f / 64.0f); float q = 0.f;
#pragma unroll
                for (int bj = 0; bj < 2; ++bj)
#pragma unroll
                    for (int n = 0; n < 2; ++n) { const f32x4 d = v[ai][bj][m][n] - mw; q += (d[0] * d[0] + d[1] * d[1]) + (d[2] * d[2] + d[3] * d[3]); }
                q += __shfl_xor(q, 16); q += __shfl_xor(q, 32);
                if (fq == 0) P[(ai * HALF + wr * 64 + m * 16 + fr) * 4 + wc] = (f32x2v){mw, q};
            }
        asm volatile("s_waitcnt lgkmcnt(0)" ::: "memory"); __builtin_amdgcn_s_barrier(); asm volatile("" ::: "memory");
#if defined(BROKEN_EXCHANGE_NO_WAIT)
#warning BROKEN CONTROL BUILD: the row-statistics exchange does not wait; results are wrong by design
        if (blockIdx.x >= 64) { const long long t0_ = clock64(); while (clock64() - t0_ < 60000) __builtin_amdgcn_s_sleep(8); }
#endif
        const int row = wid * 32 + (lane & 31);
        if (lane < 32) {
            const f32x2v a = P[row * 4 + 0], b = P[row * 4 + 1], c = P[row * 4 + 2], d = P[row * 4 + 3];
            const float mt = (a.x + b.x + c.x + d.x) * 0.25f;
            const float da = a.x - mt, db = b.x - mt, dc = c.x - mt, dd = d.x - mt;
            const float m2 = (a.y + b.y) + (c.y + d.y) + 64.0f * ((da * da + db * db) + (dc * dc + dd * dd));
            unsigned long long* slot = (unsigned long long*)xbuf + ((size_t)(u.pm * BM + row) * 4 + u.pn);
            __hip_atomic_store(slot, ((unsigned long long)__float_as_uint(m2) << 32) | __float_as_uint(mt), __ATOMIC_RELAXED, __HIP_MEMORY_SCOPE_AGENT);
        }
        asm volatile("s_waitcnt vmcnt(0)" ::: "memory");
        if (lane == 0) __hip_atomic_fetch_add(cnt + 64 * u.pm, 1u, __ATOMIC_RELAXED, __HIP_MEMORY_SCOPE_AGENT);
        if (wid == 0) {
            bool dead = false; const unsigned long long t0 = __builtin_amdgcn_s_memrealtime(); const unsigned want = 8u * (unsigned)ntn;
            for (;;) {
#if defined(BROKEN_EXCHANGE_NO_WAIT)
                break;
#endif
                if ((unsigned)__builtin_amdgcn_readfirstlane(__hip_atomic_load(cnt + 64 * u.pm, __ATOMIC_RELAXED, __HIP_MEMORY_SCOPE_AGENT)) >= want) break;
                if (__builtin_amdgcn_s_memrealtime() - t0 > 2000000ull) {
                    if (lane == 0) { unsigned expect = 0u; __hip_atomic_compare_exchange_strong(tmo + 1, &expect, code | (unsigned)(u.pm & 0xff), __ATOMIC_RELAXED, __ATOMIC_RELAXED, __HIP_MEMORY_SCOPE_AGENT);
                                     __hip_atomic_store(tmo, 1u, __ATOMIC_RELAXED, __HIP_MEMORY_SCOPE_AGENT); }
                    dead = true; break; }
                __builtin_amdgcn_s_sleep(2);
            }
            __builtin_amdgcn_fence(__ATOMIC_ACQUIRE, "agent");
            if (lane == 0) flag[0] = dead ? 1u : 0u;
        }
        asm volatile("s_waitcnt vmcnt(0) lgkmcnt(0)" ::: "memory"); __builtin_amdgcn_s_barrier(); asm volatile("" ::: "memory");
        const bool bad = flag[0] != 0u;
        if (lane < 32) {
            const unsigned long long* slot = (const unsigned long long*)xbuf + (size_t)(u.pm * BM + row) * 4; float mt[4], m2[4]; float ms = 0.f;
#pragma unroll
            for (int t = 0; t < 4; ++t) { if (t < ntn) { const unsigned long long w = __hip_atomic_load(slot + t, __ATOMIC_RELAXED, __HIP_MEMORY_SCOPE_AGENT); mt[t] = __uint_as_float((unsigned)w); m2[t] = __uint_as_float((unsigned)(w >> 32)); } else { mt[t] = 0.f; m2[t] = 0.f; } ms += mt[t]; }
            const float mean = ms / (float)ntn; float q = 0.f;
#pragma unroll
            for (int t = 0; t < 4; ++t) if (t < ntn) { const float dm = mt[t] - mean; q += m2[t] + 256.0f * dm * dm; }
            S[row] = (f32x2v){mean, 1.0f / sqrtf(q / (256.0f * (float)ntn) + eps)};
        }
        asm volatile("s_waitcnt lgkmcnt(0)" ::: "memory"); __builtin_amdgcn_s_barrier(); asm volatile("" ::: "memory");
        return bad;
    }
};
struct EpiLnRes {
    static constexpr bool PERM = false, AFTER_DRAIN = true;
    const float* base; float* out; int ldc; const float* bias; PanelStats st; unsigned poison;
    __device__ __forceinline__ void fused(f32x4 (&acc)[2][2][4][2], const Unit& u, int wr, int wc, int fr, int fq, PG8_LAS unsigned char* lds, int wid, int lane) const {
        typedef float f32x2v __attribute__((ext_vector_type(2)));
        const PG8_LAS f32x2v* S = (const PG8_LAS f32x2v*)(lds + 8192);
        const int col0 = u.pn * BM + wc * 32 + 4 * fq;
#pragma unroll
        for (int bj = 0; bj < 2; ++bj)
#pragma unroll
            for (int n = 0; n < 2; ++n) { const f32x4 bv = bias ? *(const f32x4*)(bias + col0 + bj * HALF + n * 16) : (f32x4){0.f, 0.f, 0.f, 0.f};
#pragma unroll
                for (int ai = 0; ai < 2; ++ai)
#pragma unroll
                    for (int m = 0; m < 4; ++m) acc[ai][bj][m][n] += bv; }
        f32x4 pre[4][2][2];
#pragma unroll
        for (int m = 0; m < 4; ++m) { const size_t off = (size_t)(u.pm * BM + wr * 64 + m * 16 + fr) * ldc + col0;
#pragma unroll
            for (int bj = 0; bj < 2; ++bj)
#pragma unroll
                for (int n = 0; n < 2; ++n) pre[m][bj][n] = *(const f32x4*)(base + off + bj * HALF + n * 16); }
        const bool bad = st.run(acc, u, wr, wc, fr, fq, lds, wid, lane) || poison != 0u;
        const float qnan = __builtin_nanf("");
#pragma unroll
        for (int ai = 0; ai < 2; ++ai)
#pragma unroll
            for (int m = 0; m < 4; ++m) { const int r = ai * HALF + wr * 64 + m * 16 + fr; const f32x2v sr = S[r]; const size_t off = (size_t)(u.pm * BM + r) * ldc + col0;
#pragma unroll
                for (int bj = 0; bj < 2; ++bj)
#pragma unroll
                    for (int n = 0; n < 2; ++n) { const f32x4 bs = ai == 0 ? pre[m][bj][n] : *(const f32x4*)(base + off + bj * HALF + n * 16); f32x4 o = bs + (acc[ai][bj][m][n] - sr.x) * sr.y;
                        if (bad) o = (f32x4){qnan, qnan, qnan, qnan}; *(f32x4*)(out + off + bj * HALF + n * 16) = o; }
                if (m & 1) asm volatile("" ::: "memory"); }
    }
};
struct EpiLnResLn {
    static constexpr bool PERM = false, AFTER_DRAIN = true;
    const float* base; float* out; bf16_t* xn; int ldc; const float* bias; PanelStats st1, st2; unsigned poison;
    __device__ __forceinline__ void fused(f32x4 (&acc)[2][2][4][2], const Unit& u, int wr, int wc, int fr, int fq, PG8_LAS unsigned char* lds, int wid, int lane) const {
        typedef float f32x2v __attribute__((ext_vector_type(2))); typedef unsigned u32x2v __attribute__((ext_vector_type(2)));
        const PG8_LAS f32x2v* S = (const PG8_LAS f32x2v*)(lds + 8192);
        const int col0 = u.pn * BM + wc * 32 + 4 * fq;
#pragma unroll
        for (int bj = 0; bj < 2; ++bj)
#pragma unroll
            for (int n = 0; n < 2; ++n) { const f32x4 bv = bias ? *(const f32x4*)(bias + col0 + bj * HALF + n * 16) : (f32x4){0.f, 0.f, 0.f, 0.f};
#pragma unroll
                for (int ai = 0; ai < 2; ++ai)
#pragma unroll
                    for (int m = 0; m < 4; ++m) acc[ai][bj][m][n] += bv; }
        bool bad = st1.run(acc, u, wr, wc, fr, fq, lds, wid, lane) || poison != 0u;
        const float qnan = __builtin_nanf("");
#pragma unroll
        for (int ai = 0; ai < 2; ++ai)
#pragma unroll
            for (int m = 0; m < 4; ++m) { const int r = ai * HALF + wr * 64 + m * 16 + fr; const f32x2v sr = S[r]; const size_t off = (size_t)(u.pm * BM + r) * ldc + col0;
#pragma unroll
                for (int bj = 0; bj < 2; ++bj)
#pragma unroll
                    for (int n = 0; n < 2; ++n) { const f32x4 bs = *(const f32x4*)(base + off + bj * HALF + n * 16); acc[ai][bj][m][n] = bs + (acc[ai][bj][m][n] - sr.x) * sr.y; }
                asm volatile("" : "+v"(acc[ai][0][m][0]), "+v"(acc[ai][0][m][1]), "+v"(acc[ai][1][m][0]), "+v"(acc[ai][1][m][1]));
                if (m & 1) asm volatile("" ::: "memory"); }
        const bool bad1 = bad;
        bad = st2.run(acc, u, wr, wc, fr, fq, lds, wid, lane) || bad;
#pragma unroll
        for (int ai = 0; ai < 2; ++ai)
#pragma unroll
            for (int m = 0; m < 4; ++m) { const int r = ai * HALF + wr * 64 + m * 16 + fr; const f32x2v sr = S[r]; const size_t off = (size_t)(u.pm * BM + r) * ldc + col0;
#pragma unroll
                for (int bj = 0; bj < 2; ++bj)
#pragma unroll
                    for (int n = 0; n < 2; ++n) { const f32x4 x1 = acc[ai][bj][m][n]; *(f32x4*)(out + off + bj * HALF + n * 16) = bad1 ? (f32x4){qnan, qnan, qnan, qnan} : x1;
                        const f32x4 o = (x1 - sr.x) * sr.y; u32x2v w; w.x = cvt_pk_bf16(o[0], o[1]); w.y = cvt_pk_bf16(o[2], o[3]);
                        if (bad) { w.x = 0x7fc07fc0u; w.y = 0x7fc07fc0u; } *(u32x2v*)(xn + off + bj * HALF + n * 16) = w; }
                asm volatile("" ::: "memory"); }
    }
};

template <class Epi, class Sched, bool ALIGN_EPI = false, bool SP2 = false>
__device__ __forceinline__ void gemm_phase(PG8_LAS unsigned char* lds, const Gemm g, const Sched& S, const Epi& E) {
    int tid_ = threadIdx.x; asm volatile("" : "+v"(tid_));
    const int tid = tid_, wid = __builtin_amdgcn_readfirstlane(tid >> 6), lane = tid & 63, wr = wid >> 2, wc = wid & 3, fr = lane & 15, fq = lane >> 4;
    const int K = g.K, nt = K / BK;
    unsigned voffA[2], voffB[2];
#pragma unroll
    for (int i = 0; i < 2; ++i) { int R, C; stage_rc(tid * 16 + i * 8192, R, C); const int Rb = Epi::PERM ? ((R & ~31) + perm32(R & 31)) : R;
        voffA[i] = (unsigned)(R * K + C) * 2u; voffB[i] = (unsigned)(Rb * K + C) * 2u; }
    const size_t kstep = (size_t)(BK * 2);
    const size_t hstep = (size_t)HALF * K * 2;
    const size_t tstep = 2 * hstep;
    const unsigned ldsw = (unsigned)wid * 1024u;
    const int aoff = lds_byte(wr * 64 + fr, fq * 8), boff = lds_byte(wc * 32 + fr, fq * 8);
#define PG8_SA(b, h) (((b) * 2 + (h)) * HTB)
#define PG8_SB(b, h) ((4 + (b) * 2 + (h)) * HTB)
#define PG8_STAGE(bufoff, gbase, voff) do { _Pragma("unroll") for (int _i = 0; _i < 2; ++_i) \
        __builtin_amdgcn_global_load_lds((const unsigned*)((const char*)(gbase) + (voff)[_i]), (PG8_LAS unsigned*)(lds + (bufoff) + ldsw + _i * 8192), 16, 0, 0); } while (0)
#define PG8_LDA(dst, b, h) do { _Pragma("unroll") for (int m = 0; m < 4; ++m) _Pragma("unroll") for (int k = 0; k < 2; ++k) dst[m][k] = *(const PG8_LAS bf16x8*)(lds + PG8_SA(b, h) + aoff + m * 2048 + k * 1024); } while (0)
#define PG8_LDB(dst, b, h) do { _Pragma("unroll") for (int n = 0; n < 2; ++n) _Pragma("unroll") for (int k = 0; k < 2; ++k) dst[n][k] = *(const PG8_LAS bf16x8*)(lds + PG8_SB(b, h) + boff + n * 2048 + k * 1024); } while (0)
#define PG8_MMA(ai, bj, At, Bt) do { __builtin_amdgcn_s_setprio(1); _Pragma("unroll") for (int m = 0; m < 4; ++m) _Pragma("unroll") for (int n = 0; n < 2; ++n) _Pragma("unroll") for (int k = 0; k < 2; ++k) \
        acc[ai][bj][m][n] = __builtin_amdgcn_mfma_f32_16x16x32_f16(__builtin_bit_cast(half8, Bt[n][k]), __builtin_bit_cast(half8, At[m][k]), acc[ai][bj][m][n], 0, 0, 0); __builtin_amdgcn_s_setprio(0); } while (0)
#define PG8_WAIT_V(n) asm volatile("s_waitcnt vmcnt(" #n ")" ::: "memory")
#define PG8_WAIT_L(n) asm volatile("s_waitcnt lgkmcnt(" #n ")" ::: "memory")
#define PG8_BAR __builtin_amdgcn_s_barrier()
#define PG8_SCHED __builtin_amdgcn_sched_barrier(0)
    Unit cur, nxt; int ui = 0;
    if (!S.next(0, cur)) return;
    f32x4 acc[2][2][4][2];
#pragma unroll
    for (int a = 0; a < 2; ++a)
#pragma unroll
        for (int b = 0; b < 2; ++b)
#pragma unroll
            for (int m = 0; m < 4; ++m)
#pragma unroll
                for (int n = 0; n < 2; ++n) acc[a][b][m][n] = (f32x4){0.f, 0.f, 0.f, 0.f};
    bf16x8 At[4][2], B0[2][2], B1[2][2];
    const char* cA = (const char*)g.A + (size_t)cur.pm * tstep; const char* cB = (const char*)g.Bt + (size_t)cur.pn * tstep;
    S.a_ready(cur);
    if constexpr (SP2) {
        PG8_STAGE(PG8_SB(0, 0), cB, voffB); PG8_STAGE(PG8_SB(0, 1), cB + hstep, voffB); PG8_STAGE(PG8_SA(0, 0), cA, voffA); PG8_STAGE(PG8_SA(0, 1), cA + hstep, voffA);
        if (wr == 1) PG8_BAR;
        PG8_WAIT_V(2); PG8_BAR;
        PG8_STAGE(PG8_SB(1, 0), cB + kstep, voffB); PG8_STAGE(PG8_SA(1, 0), cA + kstep, voffA); PG8_STAGE(PG8_SB(1, 1), cB + hstep + kstep, voffB);
        PG8_WAIT_V(6); PG8_BAR;
    } else {
        PG8_STAGE(PG8_SB(0, 0), cB, voffB); PG8_STAGE(PG8_SA(0, 0), cA, voffA); PG8_STAGE(PG8_SB(0, 1), cB + hstep, voffB); PG8_STAGE(PG8_SA(0, 1), cA + hstep, voffA);
        if (wr == 1) PG8_BAR;
        PG8_WAIT_V(4); PG8_BAR;
        PG8_STAGE(PG8_SB(1, 0), cB + kstep, voffB); PG8_STAGE(PG8_SA(1, 0), cA + kstep, voffA); PG8_STAGE(PG8_SB(1, 1), cB + hstep + kstep, voffB);
        PG8_WAIT_V(6); PG8_BAR;
    }
    for (;;) {
        const bool has_next = S.next(ui + 1, nxt);
        const char* nA = has_next ? (const char*)g.A + (size_t)nxt.pm * tstep : cA; const char* nB = has_next ? (const char*)g.Bt + (size_t)nxt.pn * tstep : cB;
        for (int t = 0; t < nt; t += 2) {
            const bool last = (t == nt - 2);
            const char* a1 = cA + (size_t)(t + 1) * kstep;
            const char* a2 = last ? nA : cA + (size_t)(t + 2) * kstep; const char* b2 = last ? nB : cB + (size_t)(t + 2) * kstep;
            const char* a3 = a2 + kstep; const char* b3 = b2 + kstep;
            if (last && has_next) S.a_ready(nxt);
            if constexpr (SP2) {
            PG8_LDB(B0, 0, 0); PG8_LDB(B1, 0, 1); PG8_SCHED; PG8_LDA(At, 0, 0); PG8_STAGE(PG8_SA(1, 1), a1 + hstep, voffA);
            PG8_WAIT_V(8); PG8_WAIT_L(0); PG8_BAR; PG8_MMA(0, 0, At, B0); PG8_MMA(0, 1, At, B1); PG8_BAR; PG8_SCHED;
            PG8_LDA(At, 0, 1); PG8_STAGE(PG8_SB(0, 0), b2, voffB); PG8_STAGE(PG8_SB(0, 1), b2 + hstep, voffB); PG8_STAGE(PG8_SA(0, 0), a2, voffA);
            PG8_WAIT_V(8); PG8_WAIT_L(0); PG8_BAR; PG8_MMA(1, 0, At, B0); PG8_MMA(1, 1, At, B1); PG8_BAR; PG8_SCHED;
            PG8_LDB(B0, 1, 0); PG8_LDB(B1, 1, 1); PG8_SCHED; PG8_LDA(At, 1, 0); PG8_STAGE(PG8_SA(0, 1), a2 + hstep, voffA);
            PG8_WAIT_V(8); PG8_WAIT_L(0); PG8_BAR; PG8_MMA(0, 0, At, B0); PG8_MMA(0, 1, At, B1); PG8_BAR; PG8_SCHED;
            PG8_LDA(At, 1, 1); PG8_STAGE(PG8_SB(1, 0), b3, voffB); PG8_STAGE(PG8_SB(1, 1), b3 + hstep, voffB); PG8_STAGE(PG8_SA(1, 0), a3, voffA);
            PG8_WAIT_V(8); PG8_WAIT_L(0); PG8_BAR; PG8_MMA(1, 0, At, B0); PG8_MMA(1, 1, At, B1); PG8_BAR; PG8_SCHED;
            } else {
            PG8_LDB(B0, 0, 0); PG8_SCHED; PG8_LDA(At, 0, 0); PG8_STAGE(PG8_SA(1, 1), a1 + hstep, voffA);
            PG8_WAIT_L(8); PG8_BAR; PG8_WAIT_L(0); PG8_MMA(0, 0, At, B0); PG8_BAR; PG8_SCHED;
            PG8_LDB(B1, 0, 1); PG8_STAGE(PG8_SB(0, 0), b2, voffB);
            PG8_BAR; PG8_WAIT_L(0); PG8_MMA(0, 1, At, B1); PG8_BAR;
            PG8_LDA(At, 0, 1); PG8_STAGE(PG8_SA(0, 0), a2, voffA);
            PG8_BAR; PG8_WAIT_L(0); PG8_MMA(1, 0, At, B0); PG8_BAR; PG8_SCHED;
            PG8_STAGE(PG8_SB(0, 1), b2 + hstep, voffB);
            PG8_WAIT_V(6); PG8_BAR; PG8_MMA(1, 1, At, B1); PG8_BAR;
            PG8_LDB(B0, 1, 0); PG8_SCHED; PG8_LDA(At, 1, 0); PG8_STAGE(PG8_SA(0, 1), a2 + hstep, voffA);
            PG8_WAIT_L(8); PG8_BAR; PG8_WAIT_L(0); PG8_MMA(0, 0, At, B0); PG8_BAR; PG8_SCHED;
            PG8_LDB(B1, 1, 1); PG8_STAGE(PG8_SB(1, 0), b3, voffB);
            PG8_BAR; PG8_WAIT_L(0); PG8_MMA(0, 1, At, B1); PG8_BAR;
            PG8_LDA(At, 1, 1); PG8_STAGE(PG8_SA(1, 0), a3, voffA);
            PG8_BAR; PG8_WAIT_L(0); PG8_MMA(1, 0, At, B0); PG8_BAR; PG8_SCHED;
            PG8_STAGE(PG8_SB(1, 1), b3 + hstep, voffB);
            PG8_WAIT_V(6); PG8_BAR; PG8_MMA(1, 1, At, B1); PG8_BAR;
            }
        }
        if constexpr (ALIGN_EPI) { if (wr == 0) PG8_BAR; }
        if constexpr (!Epi::AFTER_DRAIN) { E(acc, cur, wr, wc, fr, fq); S.done(cur); }
        if (!has_next) break;
#pragma unroll
        for (int a = 0; a < 2; ++a)
#pragma unroll
            for (int b = 0; b < 2; ++b)
#pragma unroll
                for (int m = 0; m < 4; ++m)
#pragma unroll
                    for (int n = 0; n < 2; ++n) acc[a][b][m][n] = (f32x4){0.f, 0.f, 0.f, 0.f};
        cur = nxt; cA = nA; cB = nB; ++ui;
        if constexpr (ALIGN_EPI) { if (wr == 1) PG8_BAR; }
    }
    PG8_WAIT_V(0);
    if constexpr (!ALIGN_EPI) { if (wr == 0) PG8_BAR; }
    PG8_BAR;
    if constexpr (Epi::AFTER_DRAIN) { E.fused(acc, cur, wr, wc, fr, fq, lds, wid, lane); S.done(cur); }
#undef PG8_SA
#undef PG8_SB
#undef PG8_STAGE
#undef PG8_LDA
#undef PG8_LDB
#undef PG8_MMA
#undef PG8_WAIT_V
#undef PG8_WAIT_L
#undef PG8_BAR
#undef PG8_SCHED
}
}

#define LAS __attribute__((address_space(3)))
typedef unsigned short bf16;
typedef float f32x4 __attribute__((ext_vector_type(4)));
typedef unsigned u32x4 __attribute__((ext_vector_type(4)));
typedef unsigned u32x2 __attribute__((ext_vector_type(2)));
constexpr int D = 1024, NB = 16, SEQ = 4096, M = NB * SEQ, CH = 64, NCHUNK = SEQ / CH;
constexpr int DIN = 3740, NP = 3840;
constexpr float LN_EPS = 1e-5f, NORM_EPS = 1e-6f, ALPHA = 1.41421356237f;
constexpr int A_BASE = 0;
constexpr int C_BASE = 1024;
constexpr int B_BASE = 2560;
constexpr int LR_COL = 3712, AC_COL = 3728, BC_COL = 3734;
__host__ __device__ inline int old_col(int n) {
    if (n < 1024) { const int h = n >> 8, r = n & 255, seg = r >> 6, c = r & 63; return seg * 256 + h * 64 + c; }
    if (n < 2560) { const int m = n - 1024, h = m >> 8, r = m & 255, seg = r >> 6, c = r & 63; return seg < 3 ? 2192 + seg * 384 + h * 64 + c : 3356 + h * 64 + c; }
    if (n < 3712) { const int m = n - 2560, h = m / 288, r = m % 288;
        if (r < 48) return 1024 + h * 48 + r; if (r < 96) return 1216 + h * 48 + (r - 48); if (r < 192) return 1408 + h * 96 + (r - 96); return 1808 + h * 96 + (r - 192); }
    if (n < 3728) return 1792 + (n - 3712);
    if (n < 3734) return 3344 + (n - 3728);
    if (n < 3740) return 3350 + (n - 3734);
    return -1;
}
constexpr size_t MiB = 1u << 20;
constexpr size_t WS_CTL = 0, WS_WIN = 1 * MiB, WS_WOUT = 16 * MiB, WS_MOD = 20 * MiB, WS_LB = 21 * MiB;
constexpr size_t WS_HY = 32 * MiB, WS_X1 = 160 * MiB, WS_PROJ = 416 * MiB, WS_END = 896 * MiB;
constexpr int LDS_BYTES = 147456;
constexpr int NTHREADS = 512;

struct Args { const float* in[17]; float* out; unsigned char* ws; int ph_lo, ph_hi; };
enum { I_X = 0, I_C, I_WIN, I_WOUT, I_ADAW, I_ADAB, I_LNG, I_LNB, I_LBL, I_WGK, I_BGK, I_CONV, I_ALOG, I_DTB, I_GA, I_GB, I_GC };

__device__ __forceinline__ unsigned f2bf(float f) { return (unsigned)__builtin_bit_cast(unsigned short, (_Float16)f); }
__device__ __forceinline__ unsigned pk2(float lo, float hi) { typedef _Float16 h2 __attribute__((ext_vector_type(2))); h2 v; v.x = (_Float16)lo; v.y = (_Float16)hi; return __builtin_bit_cast(unsigned, v); }
__device__ __forceinline__ float bf2f(bf16 b) { return (float)__builtin_bit_cast(_Float16, b); }
__device__ __forceinline__ float wave_sum(float v) {
#pragma unroll
    for (int o = 1; o < 64; o <<= 1) v += __shfl_xor(v, o);
    return v;
}
__device__ __forceinline__ float sigmoidf_(float x) { return 1.0f / (1.0f + __expf(-x)); }
__device__ __forceinline__ float siluf_(float x) { return x / (1.0f + __expf(-x)); }
__device__ __forceinline__ float softplusf_(float x) { return x > 20.f ? x : log1pf(__expf(x)); }
__device__ __forceinline__ float logsigmoidf_(float x) { return x < 0.f ? x - log1pf(__expf(x)) : -log1pf(__expf(-x)); }

__device__ __forceinline__ void p0_prep(const Args& a, unsigned char* lds_g) {
    int tid = threadIdx.x; asm volatile("" : "+v"(tid)); const int G = gridDim.x, bid = blockIdx.x;
    unsigned char* ws = a.ws;
    if (bid < 192) {
        float* cact = (float*)lds_g;
        float* part = cact + 16 * 1024;
        const float* c = a.in[I_C];
        for (int i = tid; i < 16 * 1024; i += NTHREADS) cact[i] = siluf_(c[i]);
        __syncthreads();
        const int l = bid / 96, j0 = (bid % 96) * 32, col = tid & 31, ks = tid >> 5;
        const float* W = a.in[I_ADAW] + (size_t)l * 1024 * 3072 + j0 + col;
        float acc[16];
#pragma unroll
        for (int b = 0; b < 16; ++b) acc[b] = 0.f;
        for (int k = ks * 64; k < ks * 64 + 64; ++k) {
            const float w = W[(size_t)k * 3072];
#pragma unroll
            for (int b = 0; b < 16; ++b) acc[b] += cact[b * 1024 + k] * w;
        }
#pragma unroll
        for (int b = 0; b < 16; ++b) part[(ks * 16 + b) * 32 + col] = acc[b];
        __syncthreads();
        { const int b = tid >> 5; float s = 0.f;
#pragma unroll
          for (int k2 = 0; k2 < 16; ++k2) s += part[(k2 * 16 + b) * 32 + col];
          s += a.in[I_ADAB][l * 3072 + j0 + col];
          ((float*)(ws + WS_MOD))[(size_t)(l * 16 + b) * 3072 + j0 + col] = s; }
        __syncthreads();
    }
    if (bid == 255) {
        const int l = tid >> 8, cc = tid & 255;
        const float l0 = a.in[I_LBL][cc], l1 = a.in[I_LBL][256 + cc];
        ((float*)(ws + WS_LB))[tid] = l == 0 ? 0.f : 1.0f / (1.0f + __expf(l0 - l1));
    }
    {
        const size_t gt = (size_t)bid * NTHREADS + tid, GT = (size_t)G * NTHREADS;
        bf16* WinT = (bf16*)(ws + WS_WIN);
        for (size_t idx = gt; idx < (size_t)2 * 128 * NP; idx += GT) {
            const int n = (int)(idx % NP), kb = (int)((idx / NP) % 128), l = (int)(idx / ((size_t)NP * 128));
            const int oc = old_col(n);
            float v[8];
#pragma unroll
            for (int j = 0; j < 8; ++j) v[j] = oc >= 0 ? a.in[I_WIN][((size_t)l * 1024 + kb * 8 + j) * DIN + oc] : 0.f;
            u32x4 o; o.x = pk2(v[0], v[1]); o.y = pk2(v[2], v[3]); o.z = pk2(v[4], v[5]); o.w = pk2(v[6], v[7]);
            *(u32x4*)(WinT + ((size_t)l * NP + n) * 1024 + kb * 8) = o;
        }
        bf16* WoutT = (bf16*)(ws + WS_WOUT);
        for (size_t idx = gt; idx < (size_t)2 * 128 * 1024; idx += GT) {
            const int n = (int)(idx % 1024), kb = (int)((idx / 1024) % 128), l = (int)(idx / ((size_t)1024 * 128));
            float v[8];
#pragma unroll
            for (int j = 0; j < 8; ++j) v[j] = a.in[I_WOUT][((size_t)l * 1024 + kb * 8 + j) * 1024 + n];
            u32x4 o; o.x = pk2(v[0], v[1]); o.y = pk2(v[2], v[3]); o.z = pk2(v[4], v[5]); o.w = pk2(v[6], v[7]);
            *(u32x4*)(WoutT + ((size_t)l * 1024 + n) * 1024 + kb * 8) = o;
        }
    }
}

template <int MODE>
__device__ __forceinline__ void ln_rows(const float* src, float* xo, bf16* hout, const float* lng, const float* lnb, const float* mod  ) {
    int tid = threadIdx.x; asm volatile("" : "+v"(tid));
    const int lane = tid & 63, wave = tid >> 6;
    const int gw = blockIdx.x * 8 + wave, NGW = gridDim.x * 8;
    for (int m = gw; m < M; m += NGW) {
        const f32x4* xr = (const f32x4*)(src + (size_t)m * D) + lane;
        f32x4 v[4]; float s = 0.f;
#pragma unroll
        for (int j = 0; j < 4; ++j) { v[j] = xr[64 * j]; s += (v[j].x + v[j].y) + (v[j].z + v[j].w); }
        float mean = wave_sum(s) * (1.f / D); float s2 = 0.f;
#pragma unroll
        for (int j = 0; j < 4; ++j) { v[j] = v[j] - mean; s2 += (v[j].x * v[j].x + v[j].y * v[j].y) + (v[j].z * v[j].z + v[j].w * v[j].w); }
        float rstd = 1.f / sqrtf(wave_sum(s2) * (1.f / D) + LN_EPS);
        const int b = m >> 12;
        if (MODE == 1) {
            s = 0.f;
#pragma unroll
            for (int j = 0; j < 4; ++j) { const f32x4 g = *((const f32x4*)lng + lane + 64 * j), bb = *((const f32x4*)lnb + lane + 64 * j);
                v[j] = v[j] * rstd * g + bb; *((f32x4*)(xo + (size_t)m * D) + lane + 64 * j) = v[j]; s += (v[j].x + v[j].y) + (v[j].z + v[j].w); }
            if (!hout) continue;
            mean = wave_sum(s) * (1.f / D); s2 = 0.f;
#pragma unroll
            for (int j = 0; j < 4; ++j) { v[j] = v[j] - mean; s2 += (v[j].x * v[j].x + v[j].y * v[j].y) + (v[j].z * v[j].z + v[j].w * v[j].w); }
            rstd = 1.f / sqrtf(wave_sum(s2) * (1.f / D) + LN_EPS);
        }
        const float* mb = mod + (size_t)b * 3072;
#pragma unroll
        for (int j = 0; j < 4; ++j) { const f32x4 sh = *((const f32x4*)mb + lane + 64 * j), sc = *((const f32x4*)(mb + 1024) + lane + 64 * j);
            const f32x4 h = v[j] * rstd * (sc + 1.0f) + sh;
            u32x2 w; w.x = pk2(h.x, h.y); w.y = pk2(h.z, h.w);
            *((u32x2*)(hout + (size_t)m * D) + lane + 64 * j) = w; }
    }
}

struct EpiRes {
    static constexpr bool PERM = false, AFTER_DRAIN = false;
    const float* xin; float* res; const float* gate;
    __device__ __forceinline__ void operator()(const pg8::f32x4 (&acc)[2][2][4][2], const pg8::Unit& u, int wr, int wc, int fr, int fq) const {
        const int row0 = u.pm * 256 + wr * 64 + fr, col0 = u.pn * 256 + wc * 32 + 4 * fq;
#pragma unroll
        for (int ai = 0; ai < 2; ++ai)
#pragma unroll
            for (int m = 0; m < 4; ++m) { const int row = row0 + ai * 128 + m * 16; const int b = row >> 12;
#pragma unroll
                for (int bj = 0; bj < 2; ++bj)
#pragma unroll
                    for (int n = 0; n < 2; ++n) { const int col = col0 + bj * 128 + n * 16;
                        const f32x4 g = *(const f32x4*)(gate + (size_t)b * 3072 + col), xv = *(const f32x4*)(xin + (size_t)row * D + col);
                        *(f32x4*)(res + (size_t)row * D + col) = xv * ALPHA + g * acc[ai][bj][m][n]; } }
    }
};

template <int DK, int DV, bool ISA>
__device__ __forceinline__ void mix_gla_base(const Args& a, int layer, int b, int h, float* lds) {
    constexpr int PK = DK + 1, PV = DV + 1;
    float* q = lds; float* k = q + 64 * PK; float* bc = k + 64 * PK; float* v = bc + 64 * PK; float* sc = v + 64 * PV; float* S = sc + 64 * 65; float* o = S + DK * DV; float* rinv = o + 64 * PV;
    int tid0 = threadIdx.x; asm volatile("" : "+v"(tid0));
    const bf16* proj = (const bf16*)(a.ws + WS_PROJ);
    bf16* y = (bf16*)(a.ws + WS_HY);
    const int base = ISA ? A_BASE + 256 * h : B_BASE + 288 * h;
    const int vcol = ISA ? base + 128 : base + 96, zcol = ISA ? base + 192 : base + 192;
    const int ycol = ISA ? 64 * h : 256 + 96 * h;
    const float* gain = ISA ? a.in[I_GA] + layer * 64 : a.in[I_GB] + layer * 96;
    const float* lb = (const float*)(a.ws + WS_LB) + layer * 256 + h * 64;
    const float* wgk = a.in[I_WGK] + (size_t)layer * 16 * 192 + h * 48;
    const float* bgk = a.in[I_BGK] + layer * 192 + h * 48;
    for (int i = tid0; i < DK * DV; i += NTHREADS) S[i] = 0.f;
    for (int n = 0; n < NCHUNK; ++n) {
        int tid = tid0; asm volatile("" : "+v"(tid));
        const size_t t0 = (size_t)b * SEQ + (size_t)n * 64;
        __syncthreads();
        for (int i = tid; i < 64 * DK; i += NTHREADS) { const int t = i / DK, c = i % DK; const bf16* row = proj + (t0 + t) * NP;
            if (ISA) { const float qr = bf2f(row[base + c]), fl = bf2f(row[base + 64 + c]); const float sg = sigmoidf_(fl), lbv = lb[c];
                q[t * PK + c] = siluf_(qr); const float f = lbv + (1.f - lbv) * sg; bc[t * PK + c] = __logf(fmaxf(f, 1e-30f)); k[t * PK + c] = (1.f - lbv) * sigmoidf_(-fl); }
            else { q[t * PK + c] = bf2f(row[base + c]) * 0.14433756729740643f; k[t * PK + c] = bf2f(row[base + 48 + c]);
                float s = bgk[c];
#pragma unroll
                for (int r = 0; r < 16; ++r) s += bf2f(row[LR_COL + r]) * wgk[r * 192 + c];
                bc[t * PK + c] = logsigmoidf_(s) * (1.0f / 16.0f); } }
        for (int i = tid; i < 64 * DV; i += NTHREADS) { const int t = i / DV, c = i % DV; v[t * PV + c] = bf2f(proj[(t0 + t) * NP + vcol + c]); }
        __syncthreads();
        if (tid < DK) { float run = 0.f; for (int t = 0; t < 64; ++t) { run += bc[t * PK + tid]; bc[t * PK + tid] = run; } }
        __syncthreads();
        for (int i = tid; i < 64 * 64; i += NTHREADS) { const int t = i >> 6, s = i & 63; float acc = 0.f;
            if (s <= t) for (int c = 0; c < DK; ++c) acc += q[t * PK + c] * k[s * PK + c] * __expf(bc[t * PK + c] - bc[s * PK + c]);
            sc[t * 65 + s] = acc; }
        __syncthreads();
        for (int i = tid; i < 64 * DV; i += NTHREADS) { const int t = i / DV, c = i % DV; float acc = 0.f;
            for (int s = 0; s <= t; ++s) acc += sc[t * 65 + s] * v[s * PV + c];
            for (int kk = 0; kk < DK; ++kk) acc += q[t * PK + kk] * __expf(bc[t * PK + kk]) * S[kk * DV + c];
            o[t * PV + c] = acc; }
        __syncthreads();
        for (int i = tid; i < DK * DV; i += NTHREADS) { const int kk = i / DV, c = i % DV; const float bl = bc[63 * PK + kk]; float acc = __expf(bl) * S[i];
            for (int s = 0; s < 64; ++s) acc += k[s * PK + kk] * __expf(bl - bc[s * PK + kk]) * v[s * PV + c];
            S[i] = acc; }
        if (tid < 64) { float s2 = 0.f; for (int c = 0; c < DV; ++c) s2 += o[tid * PV + c] * o[tid * PV + c]; rinv[tid] = 1.0f / sqrtf(s2 * (1.0f / DV) + NORM_EPS); }
        __syncthreads();
        for (int i = tid; i < 64 * DV; i += NTHREADS) { const int t = i / DV, c = i % DV; const float z = bf2f(proj[(t0 + t) * NP + zcol + c]);
            y[(t0 + t) * D + ycol + c] = (bf16)f2bf(o[t * PV + c] * rinv[t] * gain[c] * siluf_(z)); }
    }
}
__device__ __forceinline__ void mix_gdn_base(const Args& a, int layer, int b, int h, float* lds) {
    constexpr int P = 65;
    float* q = lds; float* k = q + 64 * P; float* v = k + 64 * P; float* L = v + 64 * P; float* at = L + 64 * P; float* U = at + 64 * P; float* W = U + 64 * P; float* S = W + 64 * P;
    float* bc = S + 64 * 64; float* beta = bc + 64; float* g = beta + 64; float* rinv = g + 64;
    int tid0 = threadIdx.x; asm volatile("" : "+v"(tid0));
    const bf16* proj = (const bf16*)(a.ws + WS_PROJ);
    bf16* y = (bf16*)(a.ws + WS_HY);
    const int base = C_BASE + 256 * h, ycol = 640 + 64 * h;
    const float* gain = a.in[I_GC] + layer * 64;
    const float* cw = a.in[I_CONV] + (size_t)layer * 4 * 1152;
    const float alog = a.in[I_ALOG][layer * 6 + h], dtb = a.in[I_DTB][layer * 6 + h];
    for (int i = tid0; i < 64 * 64; i += NTHREADS) S[i] = 0.f;
    for (int n = 0; n < NCHUNK; ++n) {
        int tid = tid0; asm volatile("" : "+v"(tid));
        const size_t t0 = (size_t)b * SEQ + (size_t)n * 64;
        __syncthreads();
        for (int i = tid; i < 64 * 192; i += NTHREADS) { const int t = i / 192, cc = i % 192, seg = cc >> 6, c = cc & 63; const int ch = seg * 384 + h * 64 + c; float acc = 0.f;
#pragma unroll
            for (int j = 0; j < 4; ++j) { const int p = n * 64 + t - 3 + j; if (p >= 0) acc += cw[j * 1152 + ch] * bf2f(proj[((size_t)b * SEQ + p) * NP + base + seg * 64 + c]); }
            const float r = siluf_(acc); (seg == 0 ? q : seg == 1 ? k : v)[t * P + c] = r; }
        if (tid < 64) { const bf16* row = proj + (t0 + tid) * NP; const float av = bf2f(row[AC_COL + h]), bv = bf2f(row[BC_COL + h]);
            g[tid] = -__expf(alog) * softplusf_(av + dtb); beta[tid] = sigmoidf_(bv); }
        __syncthreads();
        if (tid < 64) { float sq = 0.f, sk = 0.f; for (int c = 0; c < 64; ++c) { sq += q[tid * P + c] * q[tid * P + c]; sk += k[tid * P + c] * k[tid * P + c]; }
            const float nq = 0.125f / sqrtf(sq + NORM_EPS), nk = 1.0f / sqrtf(sk + NORM_EPS);
            for (int c = 0; c < 64; ++c) { q[tid * P + c] *= nq; k[tid * P + c] *= nk; } }
        if (tid == 64) { float run = 0.f; for (int t = 0; t < 64; ++t) { run += g[t]; bc[t] = run; } }
        __syncthreads();
        for (int i = tid; i < 64 * 64; i += NTHREADS) { const int t = i >> 6, s = i & 63; float kk = 0.f, qk = 0.f;
            if (s <= t) { for (int c = 0; c < 64; ++c) { kk += k[t * P + c] * k[s * P + c]; qk += q[t * P + c] * k[s * P + c]; } }
            const float dec = s <= t ? __expf(bc[t] - bc[s]) : 0.f;
            L[t * P + s] = s < t ? beta[t] * kk * dec : 0.f; at[t * P + s] = qk * dec;
            U[t * P + s] = v[t * P + s] * beta[t]; W[t * P + s] = k[t * P + s] * beta[t] * __expf(bc[t]); }
        __syncthreads();
        if (tid < 128) { float* X = (tid < 64 ? U : W); const int c = tid & 63;
            for (int t = 1; t < 64; ++t) { float acc = X[t * P + c]; for (int s = 0; s < t; ++s) acc -= L[t * P + s] * X[s * P + c]; X[t * P + c] = acc; } }
        __syncthreads();
        for (int i = tid; i < 64 * 64; i += NTHREADS) { const int t = i >> 6, c = i & 63; float acc = U[t * P + c];
            for (int kk = 0; kk < 64; ++kk) acc -= W[t * P + kk] * S[kk * 64 + c];
            U[t * P + c] = acc; }
        __syncthreads();
        for (int i = tid; i < 64 * 64; i += NTHREADS) { const int t = i >> 6, c = i & 63; float acc = 0.f; const float eb = __expf(bc[t]);
            for (int kk = 0; kk < 64; ++kk) acc += q[t * P + kk] * eb * S[kk * 64 + c];
            for (int s = 0; s <= t; ++s) acc += at[t * P + s] * U[s * P + c];
            L[t * P + c] = acc; }
        __syncthreads();
        for (int i = tid; i < 64 * 64; i += NTHREADS) { const int kk = i >> 6, c = i & 63; const float bl = bc[63]; float acc = __expf(bl) * S[i];
            for (int s = 0; s < 64; ++s) acc += k[s * P + kk] * __expf(bl - bc[s]) * U[s * P + c];
            S[i] = acc; }
        if (tid < 64) { float s2 = 0.f; for (int c = 0; c < 64; ++c) s2 += L[tid * P + c] * L[tid * P + c]; rinv[tid] = 1.0f / sqrtf(s2 * (1.0f / 64) + NORM_EPS); }
        __syncthreads();
        for (int i = tid; i < 64 * 64; i += NTHREADS) { const int t = i >> 6, c = i & 63; const float z = bf2f(proj[(t0 + t) * NP + base + 192 + c]);
            y[(t0 + t) * D + ycol + c] = (bf16)f2bf(L[t * P + c] * rinv[t] * gain[c] * siluf_(z)); }
    }
}

typedef _Float16 half8 __attribute__((ext_vector_type(8)));
typedef _Float16 half4 __attribute__((ext_vector_type(4)));
typedef short bfr8 __attribute__((ext_vector_type(8)));
constexpr int RS = 72;
constexpr int TILEB = 64 * RS * 2;
#define LDS_AT(T, off) (*(LAS T*)(L + (off)))
__device__ __forceinline__ f32x4 mfma32h(half8 a, half8 b, f32x4 c) { return __builtin_amdgcn_mfma_f32_16x16x32_f16(a, b, c, 0, 0, 0); }
__device__ __forceinline__ f32x4 mfma16h(half4 a, half4 b, f32x4 c) { return __builtin_amdgcn_mfma_f32_16x16x16f16(a, b, c, 0, 0, 0); }
__device__ __forceinline__ half4 to_h4(f32x4 x) { half4 r; r[0] = (_Float16)x[0]; r[1] = (_Float16)x[1]; r[2] = (_Float16)x[2]; r[3] = (_Float16)x[3]; return r; }
__device__ __forceinline__ half8 acc2op(f32x4 x0, f32x4 x1) { half8 r; r[0] = (_Float16)x0[0]; r[1] = (_Float16)x0[1]; r[2] = (_Float16)x0[2]; r[3] = (_Float16)x0[3];
    r[4] = (_Float16)x1[0]; r[5] = (_Float16)x1[1]; r[6] = (_Float16)x1[2]; r[7] = (_Float16)x1[3]; return r; }
__device__ __forceinline__ int swz8(int row) { return 8 * ((row >> 3) & 7); }
__device__ __forceinline__ half8 frag_std(LAS unsigned char* L, int tile, int row, int kb, int q, int sw) { return LDS_AT(half8, tile + row * (RS * 2) + (((32 * kb + 8 * q) ^ sw) * 2)); }
__device__ __forceinline__ half8 frag_perm(LAS unsigned char* L, int tile, int row, int kb, int q, int sw) {
    const half4 lo = LDS_AT(half4, tile + row * (RS * 2) + (((32 * kb + 4 * q) ^ sw) * 2)), hi = LDS_AT(half4, tile + row * (RS * 2) + (((32 * kb + 16 + 4 * q) ^ sw) * 2));
    half8 r; r[0] = lo[0]; r[1] = lo[1]; r[2] = lo[2]; r[3] = lo[3]; r[4] = hi[0]; r[5] = hi[1]; r[6] = hi[2]; r[7] = hi[3]; return r; }
__device__ __forceinline__ float h2f_lo(unsigned w) { return (float)__builtin_bit_cast(_Float16, (unsigned short)(w & 0xffffu)); }
__device__ __forceinline__ float h2f_hi(unsigned w) { return (float)__builtin_bit_cast(_Float16, (unsigned short)(w >> 16)); }
__device__ __forceinline__ float fsilu_(float x) { return x * __builtin_amdgcn_rcpf(1.0f + __expf(-x)); }
__device__ __forceinline__ float fsigmoid_(float x) { return __builtin_amdgcn_rcpf(1.0f + __expf(-x)); }
template <int CTRL, int RMASK, bool BOUND> __device__ __forceinline__ float dppmov(float x) { return __builtin_bit_cast(float, __builtin_amdgcn_update_dpp(0, __builtin_bit_cast(int, x), CTRL, RMASK, 0xf, BOUND)); }
__device__ __forceinline__ float wave_incl_scan(float x) {
    x += dppmov<0x111, 0xf, true>(x); x += dppmov<0x112, 0xf, true>(x); x += dppmov<0x114, 0xf, true>(x); x += dppmov<0x118, 0xf, true>(x);
    x += dppmov<0x142, 0xa, false>(x);
    x += dppmov<0x143, 0xc, false>(x);
    return x; }
__device__ __forceinline__ float lane_val(float x, int l) { return __builtin_bit_cast(float, __builtin_amdgcn_readlane(__builtin_bit_cast(int, x), l)); }
typedef const __attribute__((address_space(4))) float* cfloatp;
#define WG_BAR() do { asm volatile("s_waitcnt lgkmcnt(0)" ::: "memory"); __builtin_amdgcn_s_barrier(); asm volatile("" ::: "memory"); } while (0)

__device__ __forceinline__ void mix_gdn_fast(const Args& a, int layer, int b, int h, LAS unsigned char* L) {
    constexpr int O_K = 0, O_Q = TILEB, O_KT = 2 * TILEB, O_VB = 3 * TILEB, O_G = 4 * TILEB, O_AT = 5 * TILEB, O_OB = 6 * TILEB, OBS = 68;
    constexpr int O_VEC = O_OB + 64 * OBS * 4;
    constexpr int V_BC = O_VEC, V_EB = O_VEC + 256, V_CB = O_VEC + 512, V_DB = O_VEC + 768, V_BE = O_VEC + 1024, V_D = O_VEC + 1280;
    constexpr int O_CW = O_VEC + 1536;
    int tid0 = threadIdx.x; asm volatile("" : "+v"(tid0));
    const bf16* proj = (const bf16*)(a.ws + WS_PROJ);
    bf16* y = (bf16*)(a.ws + WS_HY);
    const int base = C_BASE + 256 * h, ycol = 640 + 64 * h;
    const float* gain = a.in[I_GC] + layer * 64;
    const float expA = __expf(a.in[I_ALOG][layer * 6 + h]), dtb = a.in[I_DTB][layer * 6 + h];
    for (int i = tid0; i < 2 * TILEB / 16; i += NTHREADS) LDS_AT(u32x4, O_G + 16 * i) = (u32x4){0u, 0u, 0u, 0u};
    for (int i = tid0; i < 768; i += NTHREADS) { const int j = i / 192, cc = i % 192, seg = cc >> 6, c = cc & 63; LDS_AT(float, O_CW + 4 * i) = a.in[I_CONV][(size_t)layer * 4 * 1152 + j * 1152 + seg * 384 + h * 64 + c]; }
    f32x4 S[4];
#pragma unroll
    for (int i = 0; i < 4; ++i) S[i] = (f32x4){0.f, 0.f, 0.f, 0.f};
    u32x4 raw[3][4]; u32x4 zraw, zprev = (u32x4){0u, 0u, 0u, 0u}; unsigned short ga = 0, gb = 0;
    const size_t tok0 = (size_t)b * SEQ;
#define GDN_PREFETCH(n_) do { const int tt_ = tid0 >> 3, cg_ = tid0 & 7; \
        _Pragma("unroll") for (int j_ = 0; j_ < 4; ++j_) { const int p_ = (n_) * 64 + tt_ - 3 + j_; \
            _Pragma("unroll") for (int s_ = 0; s_ < 3; ++s_) raw[s_][j_] = p_ >= 0 ? *(const u32x4*)(proj + (tok0 + p_) * NP + base + s_ * 64 + 8 * cg_) : (u32x4){0u, 0u, 0u, 0u}; } \
        zraw = *(const u32x4*)(proj + (tok0 + (n_) * 64 + tt_) * NP + base + 192 + 8 * cg_); \
        ga = proj[(tok0 + (n_) * 64 + (tid0 & 63)) * NP + AC_COL + h]; gb = proj[(tok0 + (n_) * 64 + (tid0 & 63)) * NP + BC_COL + h]; } while (0)
    GDN_PREFETCH(0);
    WG_BAR();
#pragma unroll 1
    for (int n = 0; n <= NCHUNK; ++n) {
        int tid = tid0; asm volatile("" : "+v"(tid));
        const int lane = tid & 63, wv = __builtin_amdgcn_readfirstlane(tid >> 6), t = tid >> 3, cg = tid & 7;
        if (n > 0) {
            const f32x4 o0 = LDS_AT(f32x4, O_OB + (t * OBS + 8 * cg) * 4), o1 = LDS_AT(f32x4, O_OB + (t * OBS + 8 * cg + 4) * 4);
            float s2 = (o0[0] * o0[0] + o0[1] * o0[1]) + (o0[2] * o0[2] + o0[3] * o0[3]) + (o1[0] * o1[0] + o1[1] * o1[1]) + (o1[2] * o1[2] + o1[3] * o1[3]);
            s2 += __shfl_xor(s2, 1); s2 += __shfl_xor(s2, 2); s2 += __shfl_xor(s2, 4);
            const float rinv = __builtin_amdgcn_rsqf(s2 * (1.0f / 64) + NORM_EPS);
            const f32x4 g0 = *(const f32x4*)(gain + 8 * cg), g1 = *(const f32x4*)(gain + 8 * cg + 4);
            u32x4 w;
            w.x = pk2(o0[0] * rinv * g0[0] * fsilu_(h2f_lo(zprev.x)), o0[1] * rinv * g0[1] * fsilu_(h2f_hi(zprev.x)));
            w.y = pk2(o0[2] * rinv * g0[2] * fsilu_(h2f_lo(zprev.y)), o0[3] * rinv * g0[3] * fsilu_(h2f_hi(zprev.y)));
            w.z = pk2(o1[0] * rinv * g1[0] * fsilu_(h2f_lo(zprev.z)), o1[1] * rinv * g1[1] * fsilu_(h2f_hi(zprev.z)));
            w.w = pk2(o1[2] * rinv * g1[2] * fsilu_(h2f_lo(zprev.w)), o1[3] * rinv * g1[3] * fsilu_(h2f_hi(zprev.w)));
            *(u32x4*)(y + (tok0 + (size_t)(n - 1) * 64 + t) * D + ycol + 8 * cg) = w;
        }
        if (n == NCHUNK) break;
        {
            const float gx = bf2f(ga) + dtb, la = -expA * (fmaxf(gx, 0.f) + __logf(1.0f + __expf(-fabsf(gx)))), beta_l = fsigmoid_(bf2f(gb));
            const float bcv = wave_incl_scan(la);
            const float bl = lane_val(bcv, 63);
            const float beta_t = __shfl(beta_l, t);
            if (wv == 0) { const float e = __expf(bcv); LDS_AT(float, V_BC + 4 * lane) = bcv; LDS_AT(float, V_EB + 4 * lane) = e; LDS_AT(float, V_CB + 4 * lane) = beta_l * e;
                LDS_AT(float, V_DB + 4 * lane) = __expf(bl - bcv); LDS_AT(float, V_BE + 4 * lane) = beta_l; if (lane == 0) LDS_AT(float, V_D) = __expf(bl); }
            float cv[3][8];
#pragma unroll
            for (int s = 0; s < 3; ++s) {
#pragma unroll
                for (int i = 0; i < 8; ++i) cv[s][i] = 0.f;
#pragma unroll
                for (int j = 0; j < 4; ++j) {
                    const f32x4 w0 = LDS_AT(f32x4, O_CW + (j * 192 + s * 64 + 8 * cg) * 4), w1 = LDS_AT(f32x4, O_CW + (j * 192 + s * 64 + 8 * cg + 4) * 4);
                    const u32x4 r = raw[s][j];
                    cv[s][0] += w0[0] * h2f_lo(r.x); cv[s][1] += w0[1] * h2f_hi(r.x); cv[s][2] += w0[2] * h2f_lo(r.y); cv[s][3] += w0[3] * h2f_hi(r.y);
                    cv[s][4] += w1[0] * h2f_lo(r.z); cv[s][5] += w1[1] * h2f_hi(r.z); cv[s][6] += w1[2] * h2f_lo(r.w); cv[s][7] += w1[3] * h2f_hi(r.w);
                }
#pragma unroll
                for (int i = 0; i < 8; ++i) cv[s][i] = fsilu_(cv[s][i]);
            }
            float sq = 0.f, sk = 0.f;
#pragma unroll
            for (int i = 0; i < 8; ++i) { sq += cv[0][i] * cv[0][i]; sk += cv[1][i] * cv[1][i]; }
            sq += __shfl_xor(sq, 1); sq += __shfl_xor(sq, 2); sq += __shfl_xor(sq, 4);
            sk += __shfl_xor(sk, 1); sk += __shfl_xor(sk, 2); sk += __shfl_xor(sk, 4);
            const float nq = 0.125f * __builtin_amdgcn_rsqf(sq + NORM_EPS), nk = __builtin_amdgcn_rsqf(sk + NORM_EPS);
            u32x4 wq, wk;
            wq.x = pk2(cv[0][0] * nq, cv[0][1] * nq); wq.y = pk2(cv[0][2] * nq, cv[0][3] * nq); wq.z = pk2(cv[0][4] * nq, cv[0][5] * nq); wq.w = pk2(cv[0][6] * nq, cv[0][7] * nq);
            wk.x = pk2(cv[1][0] * nk, cv[1][1] * nk); wk.y = pk2(cv[1][2] * nk, cv[1][3] * nk); wk.z = pk2(cv[1][4] * nk, cv[1][5] * nk); wk.w = pk2(cv[1][6] * nk, cv[1][7] * nk);
            LDS_AT(u32x4, O_Q + t * (RS * 2) + 16 * cg) = wq;
            LDS_AT(u32x4, O_K + t * (RS * 2) + 16 * cg) = wk;
            const int pc = (t ^ (8 * cg)) * 2;
#pragma unroll
            for (int i = 0; i < 8; ++i) {
                LDS_AT(unsigned short, O_KT + (8 * cg + i) * (RS * 2) + pc) = (unsigned short)f2bf(cv[1][i] * nk);
                LDS_AT(unsigned short, O_VB + (8 * cg + i) * (RS * 2) + pc) = (unsigned short)f2bf(cv[2][i] * beta_t);
            }
            zprev = zraw;
        }
        if (n + 1 < NCHUNK) GDN_PREFETCH(n + 1);
        WG_BAR();
        {
            const int m = lane & 15, q = lane >> 4;
            if (wv < 4) {
                const int i = wv, r0 = 16 * i;
                const half8 kf0 = frag_std(L, O_K, r0 + m, 0, q, 0), kf1 = frag_std(L, O_K, r0 + m, 1, q, 0);
                const half8 qf0 = frag_std(L, O_Q, r0 + m, 0, q, 0), qf1 = frag_std(L, O_Q, r0 + m, 1, q, 0);
                f32x4 kk = mfma32h(kf0, kf0, (f32x4){0.f, 0.f, 0.f, 0.f}); kk = mfma32h(kf1, kf1, kk);
                f32x4 qk = mfma32h(kf0, qf0, (f32x4){0.f, 0.f, 0.f, 0.f}); qk = mfma32h(kf1, qf1, qk);
                const float bc_n = LDS_AT(float, V_BC + 4 * (r0 + m)), be_n = LDS_AT(float, V_BE + 4 * (r0 + m));
                const f32x4 bc_r = LDS_AT(f32x4, V_BC + 4 * (r0 + 4 * q)), be_r = LDS_AT(f32x4, V_BE + 4 * (r0 + 4 * q));
                f32x4 Lc, Ltc, Pc, Ptc, atv;
#pragma unroll
                for (int r = 0; r < 4; ++r) { const int rr = 4 * q + r;
                    const float e_rn = __expf(fminf(bc_r[r] - bc_n, 0.f)), e_nr = __expf(fminf(bc_n - bc_r[r], 0.f));
                    Lc[r] = (m < rr) ? be_r[r] * kk[r] * e_rn : 0.f;
                    Ltc[r] = (rr < m) ? be_n * kk[r] * e_nr : 0.f;
                    atv[r] = (rr <= m) ? qk[r] * e_nr : 0.f;
                    const float id = (rr == m) ? 1.f : 0.f; Pc[r] = id - Lc[r]; Ptc[r] = id - Ltc[r]; }
                const f32x4 Z = (f32x4){0.f, 0.f, 0.f, 0.f};
                const half4 hM = to_h4(Lc), hMt = to_h4(Ltc), hPt = to_h4(Ptc);
                const f32x4 M2 = mfma16h(hMt, hM, Z), M2t = mfma16h(hM, hMt, Z);
                const half4 hM2 = to_h4(M2), hM2t = to_h4(M2t);
                const f32x4 P2t = mfma16h(hM2, hPt, Ptc);
                const f32x4 M4 = mfma16h(hM2t, hM2, Z), M4t = mfma16h(hM2, hM2t, Z);
                const half4 hM4 = to_h4(M4), hM4t = to_h4(M4t), hP2t = to_h4(P2t);
                const f32x4 P3t = mfma16h(hM4, hP2t, P2t);
                const f32x4 M8 = mfma16h(hM4t, hM4, Z);
                const half4 hM8 = to_h4(M8), hP3t = to_h4(P3t);
                const f32x4 Dt = mfma16h(hM8, hP3t, P3t);
                (void)Pc;
                LDS_AT(half4, O_G + (r0 + m) * (RS * 2) + (r0 + 4 * q) * 2) = to_h4(Dt);
                LDS_AT(half4, O_AT + (r0 + m) * (RS * 2) + (r0 + 4 * q) * 2) = to_h4(atv);
            } else {
#pragma unroll
                for (int rep = 0; rep < 2; ++rep) {
                    int ti, tj;
                    if (rep == 0) { ti = wv == 4 ? 1 : wv == 7 ? 3 : 2; tj = wv == 6 ? 1 : 0; }
                    else { if (wv >= 6) break; ti = 3; tj = wv == 4 ? 1 : 2; }
                    const half8 kj0 = frag_std(L, O_K, 16 * tj + m, 0, q, 0), kj1 = frag_std(L, O_K, 16 * tj + m, 1, q, 0);
                    const half8 ki0 = frag_std(L, O_K, 16 * ti + m, 0, q, 0), ki1 = frag_std(L, O_K, 16 * ti + m, 1, q, 0);
                    const half8 qi0 = frag_std(L, O_Q, 16 * ti + m, 0, q, 0), qi1 = frag_std(L, O_Q, 16 * ti + m, 1, q, 0);
                    f32x4 kk = mfma32h(kj0, ki0, (f32x4){0.f, 0.f, 0.f, 0.f}); kk = mfma32h(kj1, ki1, kk);
                    f32x4 qk = mfma32h(kj0, qi0, (f32x4){0.f, 0.f, 0.f, 0.f}); qk = mfma32h(kj1, qi1, qk);
                    const float bc_t = LDS_AT(float, V_BC + 4 * (16 * ti + m)), be_t = LDS_AT(float, V_BE + 4 * (16 * ti + m));
                    const f32x4 bc_s = LDS_AT(f32x4, V_BC + 4 * (16 * tj + 4 * q));
                    f32x4 gv, av;
#pragma unroll
                    for (int r = 0; r < 4; ++r) { const float e = __expf(fminf(bc_t - bc_s[r], 0.f)); gv[r] = -be_t * kk[r] * e; av[r] = qk[r] * e; }
                    LDS_AT(half4, O_G + (16 * ti + m) * (RS * 2) + (16 * tj + 4 * q) * 2) = to_h4(gv);
                    LDS_AT(half4, O_AT + (16 * ti + m) * (RS * 2) + (16 * tj + 4 * q) * 2) = to_h4(av);
                }
            }
        }
        WG_BAR();
        if (wv < 4) {
            const int m = lane & 15, q = lane >> 4, c = wv;
            const f32x4 Z = (f32x4){0.f, 0.f, 0.f, 0.f};
            const half8 Sop0 = acc2op(S[0], S[1]), Sop1 = acc2op(S[2], S[3]);
            const int vrow = 16 * c + m, vsw = swz8(vrow);
            f32x4 rr[4];
#pragma unroll
            for (int rt = 0; rt < 4; ++rt) {
                f32x4 acc = mfma32h(frag_perm(L, O_K, 16 * rt + m, 0, q, 0), Sop0, Z); acc = mfma32h(frag_perm(L, O_K, 16 * rt + m, 1, q, 0), Sop1, acc);
                const half4 vb = LDS_AT(half4, O_VB + vrow * (RS * 2) + (((16 * rt + 4 * q) ^ vsw) * 2));
                const f32x4 cb = LDS_AT(f32x4, V_CB + 4 * (16 * rt + 4 * q));
#pragma unroll
                for (int r = 0; r < 4; ++r) rr[rt][r] = (float)vb[r] - cb[r] * acc[r];
            }
            const half8 g00 = frag_perm(L, O_G, 0 + m, 0, q, 0), g10 = frag_perm(L, O_G, 16 + m, 0, q, 0), g20 = frag_perm(L, O_G, 32 + m, 0, q, 0), g21 = frag_perm(L, O_G, 32 + m, 1, q, 0),
                        g30 = frag_perm(L, O_G, 48 + m, 0, q, 0), g31 = frag_perm(L, O_G, 48 + m, 1, q, 0);
            const f32x4 v0 = mfma32h(g00, acc2op(rr[0], Z), Z);
            const f32x4 a1 = mfma32h(g10, acc2op(v0, Z), rr[1]);
            const f32x4 v1 = mfma32h(g10, acc2op(Z, a1), Z);
            const half8 v01 = acc2op(v0, v1);
            const f32x4 a2 = mfma32h(g20, v01, rr[2]);
            const f32x4 v2 = mfma32h(g21, acc2op(a2, Z), Z);
            f32x4 a3 = mfma32h(g30, v01, rr[3]); a3 = mfma32h(g31, acc2op(v2, Z), a3);
            const f32x4 v3 = mfma32h(g31, acc2op(Z, a3), Z);
            const half8 v23 = acc2op(v2, v3);
#pragma unroll
            for (int rt = 0; rt < 4; ++rt) {
                f32x4 acc = mfma32h(frag_perm(L, O_Q, 16 * rt + m, 0, q, 0), Sop0, Z); acc = mfma32h(frag_perm(L, O_Q, 16 * rt + m, 1, q, 0), Sop1, acc);
                const f32x4 eb = LDS_AT(f32x4, V_EB + 4 * (16 * rt + 4 * q));
                acc = acc * eb;
                acc = mfma32h(frag_perm(L, O_AT, 16 * rt + m, 0, q, 0), v01, acc);
                if (rt >= 2) acc = mfma32h(frag_perm(L, O_AT, 16 * rt + m, 1, q, 0), v23, acc);
#pragma unroll
                for (int r = 0; r < 4; ++r) LDS_AT(float, O_OB + ((16 * rt + 4 * q + r) * OBS + 16 * c + m) * 4) = acc[r];
            }
            const f32x4 db0 = LDS_AT(f32x4, V_DB + 4 * (4 * q)), db1 = LDS_AT(f32x4, V_DB + 4 * (16 + 4 * q)), db2 = LDS_AT(f32x4, V_DB + 4 * (32 + 4 * q)), db3 = LDS_AT(f32x4, V_DB + 4 * (48 + 4 * q));
            const half8 w01 = acc2op(v0 * db0, v1 * db1), w23 = acc2op(v2 * db2, v3 * db3);
            const float dsc = LDS_AT(float, V_D);
#pragma unroll
            for (int rt = 0; rt < 4; ++rt) { const int krow = 16 * rt + m, ksw = swz8(krow);
                f32x4 acc = S[rt] * dsc;
                acc = mfma32h(frag_perm(L, O_KT, krow, 0, q, ksw), w01, acc); acc = mfma32h(frag_perm(L, O_KT, krow, 1, q, ksw), w23, acc);
                S[rt] = acc; }
        }
        WG_BAR();
    }
#undef GDN_PREFETCH
}

__device__ __forceinline__ unsigned pk2b(float lo, float hi) { unsigned r; asm volatile("v_cvt_pk_bf16_f32 %0, %1, %2" : "=v"(r) : "v"(lo), "v"(hi)); return r; }
__device__ __forceinline__ f32x4 mfma32b(bfr8 a, bfr8 b, f32x4 c) { return __builtin_amdgcn_mfma_f32_16x16x32_bf16(a, b, c, 0, 0, 0); }
template <int DK, int DV, bool ISA>
__device__ __forceinline__ void mix_gla_fast(const Args& a, int layer, int b, int h, LAS unsigned char* L) {
    constexpr int O_QS = 0, O_KV = TILEB, O_P = O_KV + TILEB, O_QT = O_P + TILEB, O_KST = O_QT + TILEB, O_VT = O_KST + TILEB, O_OB = O_VT + DV * RS * 2, OBS = DV + 4;
    constexpr int V_DS = O_OB + 64 * OBS * 4, LDS_END = V_DS + 256;
    static_assert(LDS_END <= LDS_BYTES, "GLA LDS map");
    constexpr int NGW = DK / 8;
    constexpr int NG2 = DV / 8 - 8;
    int tid0 = threadIdx.x; asm volatile("" : "+v"(tid0));
    const bf16* proj = (const bf16*)(a.ws + WS_PROJ);
    bf16* y = (bf16*)(a.ws + WS_HY);
    const int base = ISA ? A_BASE + 256 * h : B_BASE + 288 * h;
    const int vcol = ISA ? base + 128 : base + 96, zcol = base + 192, ycol = ISA ? 64 * h : 256 + 96 * h;
    const float* gain = ISA ? a.in[I_GA] + layer * 64 : a.in[I_GB] + layer * 96;
    const float* lb = (const float*)(a.ws + WS_LB) + layer * 256 + h * 64;
    const float* wgk = a.in[I_WGK] + (size_t)layer * 16 * 192 + h * 48;
    const float* bgk = a.in[I_BGK] + layer * 192 + h * 48;
    for (int i = tid0; i < O_OB / 16; i += NTHREADS) LDS_AT(u32x4, 16 * i) = (u32x4){0u, 0u, 0u, 0u};
    if (tid0 < 64) LDS_AT(float, V_DS + 4 * tid0) = 1.f;
    f32x4 S[4];
#pragma unroll
    for (int i = 0; i < 4; ++i) S[i] = (f32x4){0.f, 0.f, 0.f, 0.f};
    const u32x4 Z4 = (u32x4){0u, 0u, 0u, 0u};
    u32x4 qraw = Z4, fraw = Z4, lr0 = Z4, lr1 = Z4, vraw = Z4, vraw2 = Z4, zraw = Z4, zraw2 = Z4, zprev = Z4, zprev2 = Z4;
    const size_t tok0 = (size_t)b * SEQ;
#define GLA_PREFETCH(n_) do { const int w_ = tid0 >> 6, ln_ = tid0 & 63, tv_ = tid0 >> 3, pt_ = tid0 & 7; \
        if (w_ < NGW) { const bf16* row_ = proj + (tok0 + (n_) * 64 + ln_) * NP; qraw = *(const u32x4*)(row_ + base + 8 * w_); fraw = *(const u32x4*)(row_ + base + (ISA ? 64 : 48) + 8 * w_); \
            if (!ISA) { lr0 = *(const u32x4*)(row_ + LR_COL); lr1 = *(const u32x4*)(row_ + LR_COL + 8); } } \
        { const bf16* row_ = proj + (tok0 + (n_) * 64 + tv_) * NP; vraw = *(const u32x4*)(row_ + vcol + 8 * pt_); zraw = *(const u32x4*)(row_ + zcol + 8 * pt_); \
            if (NG2 > 0 && pt_ < NG2) { vraw2 = *(const u32x4*)(row_ + vcol + 64 + 8 * pt_); zraw2 = *(const u32x4*)(row_ + zcol + 64 + 8 * pt_); } } } while (0)
    GLA_PREFETCH(0);
    WG_BAR();
#pragma unroll 1
    for (int n = 0; n <= NCHUNK; ++n) {
        int tid = tid0; asm volatile("" : "+v"(tid));
        const int lane = tid & 63, wv = __builtin_amdgcn_readfirstlane(tid >> 6), tv = tid >> 3, pt = tid & 7;
        if (n > 0) {
            const f32x4 o0 = LDS_AT(f32x4, O_OB + (tv * OBS + 8 * pt) * 4), o1 = LDS_AT(f32x4, O_OB + (tv * OBS + 8 * pt + 4) * 4);
            f32x4 o2 = (f32x4){0.f, 0.f, 0.f, 0.f}, o3 = o2;
            if (NG2 > 0 && pt < NG2) { o2 = LDS_AT(f32x4, O_OB + (tv * OBS + 64 + 8 * pt) * 4); o3 = LDS_AT(f32x4, O_OB + (tv * OBS + 64 + 8 * pt + 4) * 4); }
            float s2 = (o0[0] * o0[0] + o0[1] * o0[1]) + (o0[2] * o0[2] + o0[3] * o0[3]) + (o1[0] * o1[0] + o1[1] * o1[1]) + (o1[2] * o1[2] + o1[3] * o1[3]);
            s2 += (o2[0] * o2[0] + o2[1] * o2[1]) + (o2[2] * o2[2] + o2[3] * o2[3]) + (o3[0] * o3[0] + o3[1] * o3[1]) + (o3[2] * o3[2] + o3[3] * o3[3]);
            s2 += __shfl_xor(s2, 1); s2 += __shfl_xor(s2, 2); s2 += __shfl_xor(s2, 4);
            const float rinv = __builtin_amdgcn_rsqf(s2 * (1.0f / DV) + NORM_EPS);
            bf16* yrow = y + (tok0 + (size_t)(n - 1) * 64 + tv) * D + ycol;
            { const f32x4 g0 = *(const f32x4*)(gain + 8 * pt), g1 = *(const f32x4*)(gain + 8 * pt + 4); u32x4 w;
              w.x = pk2(o0[0] * rinv * g0[0] * fsilu_(h2f_lo(zprev.x)), o0[1] * rinv * g0[1] * fsilu_(h2f_hi(zprev.x)));
              w.y = pk2(o0[2] * rinv * g0[2] * fsilu_(h2f_lo(zprev.y)), o0[3] * rinv * g0[3] * fsilu_(h2f_hi(zprev.y)));
              w.z = pk2(o1[0] * rinv * g1[0] * fsilu_(h2f_lo(zprev.z)), o1[1] * rinv * g1[1] * fsilu_(h2f_hi(zprev.z)));
              w.w = pk2(o1[2] * rinv * g1[2] * fsilu_(h2f_lo(zprev.w)), o1[3] * rinv * g1[3] * fsilu_(h2f_hi(zprev.w)));
              *(u32x4*)(yrow + 8 * pt) = w; }
            if (NG2 > 0 && pt < NG2) { const f32x4 g0 = *(const f32x4*)(gain + 64 + 8 * pt), g1 = *(const f32x4*)(gain + 64 + 8 * pt + 4); u32x4 w;
              w.x = pk2(o2[0] * rinv * g0[0] * fsilu_(h2f_lo(zprev2.x)), o2[1] * rinv * g0[1] * fsilu_(h2f_hi(zprev2.x)));
              w.y = pk2(o2[2] * rinv * g0[2] * fsilu_(h2f_lo(zprev2.y)), o2[3] * rinv * g0[3] * fsilu_(h2f_hi(zprev2.y)));
              w.z = pk2(o3[0] * rinv * g1[0] * fsilu_(h2f_lo(zprev2.z)), o3[1] * rinv * g1[1] * fsilu_(h2f_hi(zprev2.z)));
              w.w = pk2(o3[2] * rinv * g1[2] * fsilu_(h2f_lo(zprev2.w)), o3[3] * rinv * g1[3] * fsilu_(h2f_hi(zprev2.w)));
              *(u32x4*)(yrow + 64 + 8 * pt) = w; }
        }
        if (n == NCHUNK) break;
        if (wv < NGW) {
            float qv[8], kv[8], bc[8];
            const unsigned qw[4] = {qraw.x, qraw.y, qraw.z, qraw.w}, fw[4] = {fraw.x, fraw.y, fraw.z, fraw.w};
            if (ISA) {
                const cfloatp lbc = (cfloatp)lb;
#pragma unroll
                for (int i = 0; i < 8; ++i) { const float qr = (i & 1) ? h2f_hi(qw[i >> 1]) : h2f_lo(qw[i >> 1]), fl = (i & 1) ? h2f_hi(fw[i >> 1]) : h2f_lo(fw[i >> 1]);
                    const float lbv = lbc[8 * wv + i], e = __expf(-fmaxf(fl, -30.f)), sg = __builtin_amdgcn_rcpf(1.0f + e);
                    qv[i] = fsilu_(qr); kv[i] = (1.f - lbv) * (e * sg); bc[i] = __logf(fmaxf(lbv + (1.f - lbv) * sg, 1e-30f)); }
            } else {
                float lrv[16];
                const unsigned lw[8] = {lr0.x, lr0.y, lr0.z, lr0.w, lr1.x, lr1.y, lr1.z, lr1.w};
                const cfloatp wgc = (cfloatp)wgk; const cfloatp bgc = (cfloatp)bgk;
#pragma unroll
                for (int r = 0; r < 16; ++r) lrv[r] = (r & 1) ? h2f_hi(lw[r >> 1]) : h2f_lo(lw[r >> 1]);
#pragma unroll
                for (int i = 0; i < 8; ++i) { float s = bgc[8 * wv + i];
#pragma unroll
                    for (int r = 0; r < 16; ++r) s += lrv[r] * wgc[r * 192 + 8 * wv + i];
                    qv[i] = ((i & 1) ? h2f_hi(qw[i >> 1]) : h2f_lo(qw[i >> 1])) * 0.14433756729740643f; kv[i] = (i & 1) ? h2f_hi(fw[i >> 1]) : h2f_lo(fw[i >> 1]);
                    bc[i] = -(fmaxf(-s, 0.f) + __logf(1.0f + __expf(-fabsf(s)))) * (1.0f / 16.0f); }
            }
            float qs[8], qt[8], kk[8], kst[8];
#pragma unroll
            for (int i = 0; i < 8; ++i) {
                bc[i] = wave_incl_scan(bc[i]);
                const float Bmid = lane_val(bc[i], 31);
                const float e1 = __expf(fminf(bc[i] - Bmid, 80.f)), e2 = __expf(fminf(Bmid - bc[i], 80.f)), e3 = __expf(bc[i]);
                qs[i] = qv[i] * e1; kk[i] = kv[i] * e2; qt[i] = qv[i] * e3;
                kst[i] = kk[i] * lane_val(e1, 63);
                if (lane == 0) LDS_AT(float, V_DS + 4 * (8 * wv + i)) = lane_val(e3, 63);
            }
            u32x4 w;
            w.x = pk2b(qs[0], qs[1]); w.y = pk2b(qs[2], qs[3]); w.z = pk2b(qs[4], qs[5]); w.w = pk2b(qs[6], qs[7]); LDS_AT(u32x4, O_QS + lane * (RS * 2) + 16 * wv) = w;
            w.x = pk2b(kk[0], kk[1]); w.y = pk2b(kk[2], kk[3]); w.z = pk2b(kk[4], kk[5]); w.w = pk2b(kk[6], kk[7]); LDS_AT(u32x4, O_KV + lane * (RS * 2) + 16 * wv) = w;
            w.x = pk2(qt[0], qt[1]); w.y = pk2(qt[2], qt[3]); w.z = pk2(qt[4], qt[5]); w.w = pk2(qt[6], qt[7]); LDS_AT(u32x4, O_QT + lane * (RS * 2) + 16 * wv) = w;
            const int pc = (lane ^ (8 * wv)) * 2;
#pragma unroll
            for (int i = 0; i < 8; ++i) LDS_AT(unsigned short, O_KST + (8 * wv + i) * (RS * 2) + pc) = (unsigned short)f2bf(kst[i]);
        }
        {
            const unsigned vw[4] = {vraw.x, vraw.y, vraw.z, vraw.w};
            const int pc = (tv ^ (8 * pt)) * 2;
#pragma unroll
            for (int i = 0; i < 8; ++i) LDS_AT(unsigned short, O_VT + (8 * pt + i) * (RS * 2) + pc) = (unsigned short)((i & 1) ? (vw[i >> 1] >> 16) : (vw[i >> 1] & 0xffffu));
            if (NG2 > 0 && pt < NG2) { const unsigned vw2[4] = {vraw2.x, vraw2.y, vraw2.z, vraw2.w};
#pragma unroll
                for (int i = 0; i < 8; ++i) LDS_AT(unsigned short, O_VT + (64 + 8 * pt + i) * (RS * 2) + pc) = (unsigned short)((i & 1) ? (vw2[i >> 1] >> 16) : (vw2[i >> 1] & 0xffffu)); }
            zprev = zraw; zprev2 = zraw2;
        }
        if (n + 1 < NCHUNK) GLA_PREFETCH(n + 1);
        WG_BAR();
        {
            const int m = lane & 15, q = lane >> 4;
#pragma unroll
            for (int rep = 0; rep < 2; ++rep) {
                const int tix = wv + 8 * rep; if (tix >= 10) break;
                const int ti = tix == 0 ? 0 : tix <= 2 ? 1 : tix <= 5 ? 2 : 3, tj = tix - (ti * (ti + 1)) / 2;
                const bfr8 a0 = LDS_AT(bfr8, O_KV + (16 * tj + m) * (RS * 2) + (8 * q) * 2), a1 = LDS_AT(bfr8, O_KV + (16 * tj + m) * (RS * 2) + (32 + 8 * q) * 2);
                const bfr8 b0 = LDS_AT(bfr8, O_QS + (16 * ti + m) * (RS * 2) + (8 * q) * 2), b1 = LDS_AT(bfr8, O_QS + (16 * ti + m) * (RS * 2) + (32 + 8 * q) * 2);
                f32x4 p = mfma32b(a0, b0, (f32x4){0.f, 0.f, 0.f, 0.f}); p = mfma32b(a1, b1, p);
                if (ti == tj) {
#pragma unroll
                    for (int r = 0; r < 4; ++r) if (4 * q + r > m) p[r] = 0.f; }
                LDS_AT(half4, O_P + (16 * ti + m) * (RS * 2) + (16 * tj + 4 * q) * 2) = to_h4(p);
            }
        }
        WG_BAR();
        if (wv < DV / 16) {
            const int m = lane & 15, q = lane >> 4, c = wv;
            const f32x4 Z = (f32x4){0.f, 0.f, 0.f, 0.f};
            const half8 Sop0 = acc2op(S[0], S[1]), Sop1 = acc2op(S[2], S[3]);
            const int vrow = 16 * c + m, vsw = swz8(vrow);
            const half8 vf0 = frag_std(L, O_VT, vrow, 0, q, vsw), vf1 = frag_std(L, O_VT, vrow, 1, q, vsw);
#pragma unroll
            for (int rt = 0; rt < 4; ++rt) {
                f32x4 acc = mfma32h(frag_std(L, O_P, 16 * rt + m, 0, q, 0), vf0, Z);
                if (rt >= 2) acc = mfma32h(frag_std(L, O_P, 16 * rt + m, 1, q, 0), vf1, acc);
                acc = mfma32h(frag_perm(L, O_QT, 16 * rt + m, 0, q, 0), Sop0, acc); acc = mfma32h(frag_perm(L, O_QT, 16 * rt + m, 1, q, 0), Sop1, acc);
#pragma unroll
                for (int r = 0; r < 4; ++r) LDS_AT(float, O_OB + ((16 * rt + 4 * q + r) * OBS + 16 * c + m) * 4) = acc[r];
            }
#pragma unroll
            for (int rt = 0; rt < 4; ++rt) { const int krow = 16 * rt + m, ksw = swz8(krow);
                const f32x4 ds = LDS_AT(f32x4, V_DS + 4 * (16 * rt + 4 * q));
                f32x4 acc = S[rt] * ds;
                acc = mfma32h(frag_std(L, O_KST, krow, 0, q, ksw), vf0, acc); acc = mfma32h(frag_std(L, O_KST, krow, 1, q, ksw), vf1, acc);
                S[rt] = acc; }
        }
        WG_BAR();
    }
#undef GLA_PREFETCH
}
#ifndef FAST_A
#define FAST_A 0
#endif
#ifndef FAST_B
#define FAST_B 0
#endif
#ifndef FAST_C
#define FAST_C 0
#endif
__device__ __forceinline__ void p3_mixers(const Args& a, int layer, unsigned char* lds_g) {
    const int id = blockIdx.x;
    if (id < 96) {
#if FAST_C
        mix_gdn_fast(a, layer, id / 6, id % 6, (LAS unsigned char*)lds_g);
#else
        mix_gdn_base(a, layer, id / 6, id % 6, (float*)lds_g);
#endif
    } else if (id < 160) {
#if FAST_A
        mix_gla_fast<64, 64, true>(a, layer, (id - 96) >> 2, (id - 96) & 3, (LAS unsigned char*)lds_g);
#else
        mix_gla_base<64, 64, true>(a, layer, (id - 96) >> 2, (id - 96) & 3, (float*)lds_g);
#endif
    } else if (id < 224) {
#if FAST_B
        mix_gla_fast<48, 96, false>(a, layer, (id - 160) >> 2, (id - 160) & 3, (LAS unsigned char*)lds_g);
#else
        mix_gla_base<48, 96, false>(a, layer, (id - 160) >> 2, (id - 160) & 3, (float*)lds_g);
#endif
    }
}
#ifndef MK_ONE_LAUNCH
#define MK_ONE_LAUNCH 0
#endif
constexpr int N_PHASES = 10;
template <int PLO, int PHI> __global__ void __launch_bounds__(NTHREADS, 2) mega(Args args_) {
    extern __shared__ __attribute__((aligned(16))) unsigned char lds[];
#if defined(__HIP_DEVICE_COMPILE__)
#define ARGS() const Args args = *({ const __attribute__((address_space(4))) Args* ap_ = (const __attribute__((address_space(4))) Args*)__builtin_amdgcn_kernarg_segment_ptr(); asm volatile("" : "+s"(ap_)); ap_; })
#else
#define ARGS() const Args args = args_
#endif
    constexpr int lo = PLO, hi = PHI;
#define IN(k) (lo <= (k) && (k) < hi)
#define SEAM(k) do { if (IN(k) && IN((k) + 1)) { cg::this_grid().sync(); } } while (0)
#define WSP(T, off) ((T*)(args.ws + (off)))
    if (IN(0)) { ARGS(); p0_prep(args, lds); }
    SEAM(0);
    if (IN(1)) { ARGS(); ln_rows<0>(args.in[I_X], nullptr, WSP(bf16, WS_HY), nullptr, nullptr, WSP(float, WS_MOD)); }
    SEAM(1);
#pragma unroll
    for (int l = 0; l < 2; ++l) {
        const int p = 2 + 4 * l;
        if (IN(p)) { ARGS();
            pg8::Gemm g{WSP(bf16, WS_HY), WSP(bf16, WS_WIN) + (size_t)l * NP * 1024, M, NP, D}; pg8::StaticOrder S; S.init(M, NP, gridDim.x, (int)blockIdx.x);
            pg8::EpiBf16<0> E{WSP(bf16, WS_PROJ), NP, nullptr, 0, 0, 1.f};
            pg8::gemm_phase<pg8::EpiBf16<0>, pg8::StaticOrder, true, true>((PG8_LAS unsigned char*)lds, g, S, E);
        }
        SEAM(p);
        if (IN(p + 1)) { ARGS(); p3_mixers(args, l, lds);
#ifdef PROBE_MIX2
            __syncthreads(); p3_mixers(args, l, lds);
#endif
        }
        SEAM(p + 1);
        if (IN(p + 2)) { ARGS();
            const float* xin = l == 0 ? args.in[I_X] : WSP(float, WS_X1);
            pg8::Gemm g{WSP(bf16, WS_HY), WSP(bf16, WS_WOUT) + (size_t)l * 1024 * 1024, M, D, D}; pg8::StaticOrder S; S.init(M, D, gridDim.x, (int)blockIdx.x);
            EpiRes E{xin, args.out, WSP(float, WS_MOD) + (size_t)l * 16 * 3072 + 2048};
            pg8::gemm_phase<EpiRes, pg8::StaticOrder, true, true>((PG8_LAS unsigned char*)lds, g, S, E);
        }
        SEAM(p + 2);
        if (IN(p + 3)) { ARGS();
            if (l == 0) ln_rows<1>(args.out, WSP(float, WS_X1), WSP(bf16, WS_HY), args.in[I_LNG], args.in[I_LNB], WSP(float, WS_MOD) + (size_t)16 * 3072);
            else ln_rows<1>(args.out, args.out, nullptr, args.in[I_LNG] + 1024, args.in[I_LNB] + 1024, nullptr);
        }
        if (l == 0) SEAM(p + 3);
    }
#undef WSP
#undef ARGS
#undef IN
#undef SEAM
}

#include <utility>
template <int P> static hipError_t set_attr1() { return hipFuncSetAttribute((const void*)mega<P, P + 1>, hipFuncAttributeMaxDynamicSharedMemorySize, LDS_BYTES); }
template <int... P> static hipError_t set_attrs_(std::integer_sequence<int, P...>) { hipError_t e = hipSuccess; hipError_t r[] = {set_attr1<P>()...}; for (hipError_t x : r) if (x != hipSuccess) e = x; return e; }
static hipError_t set_attrs() {
#if MK_ONE_LAUNCH
    return hipFuncSetAttribute((const void*)mega<0, N_PHASES>, hipFuncAttributeMaxDynamicSharedMemorySize, LDS_BYTES);
#else
    return set_attrs_(std::make_integer_sequence<int, N_PHASES>{});
#endif
}
template <int P> static int launch1(const Args& a, int grid, hipStream_t stream) { hipLaunchKernelGGL((mega<P, P + 1>), dim3(grid), dim3(NTHREADS), LDS_BYTES, stream, a); return 0; }
template <int... P> static void launch_all(const Args& a, int grid, hipStream_t stream, std::integer_sequence<int, P...>) { int r[] = {launch1<P>(a, grid, stream)...}; (void)r; }
extern "C" void kernel_launch(void* const* d_in, const int* in_sizes, int n_in, void* d_out, int out_size, void* d_ws, size_t ws_size, hipStream_t stream) {
    static int grid = 0;
    if (grid == 0) {
        if (n_in != 17 || out_size != M * D || ws_size < WS_END) { fprintf(stderr, "kernel_launch: unexpected shapes (n_in %d out %d ws %zu)\n", n_in, out_size, ws_size); grid = -1; return; }
        if (set_attrs() != hipSuccess) { fprintf(stderr, "kernel_launch: hipFuncSetAttribute failed\n"); grid = -1; return; }
        int dev = 0, cus = 0, per_cu = 0;
        (void)hipGetDevice(&dev); (void)hipDeviceGetAttribute(&cus, hipDeviceAttributeMultiprocessorCount, dev);
#if MK_ONE_LAUNCH
        (void)hipOccupancyMaxActiveBlocksPerMultiprocessor(&per_cu, (const void*)mega<0, N_PHASES>, NTHREADS, LDS_BYTES);
#else
        per_cu = 1;
#endif
        if (per_cu < 1 || cus < 256) { fprintf(stderr, "kernel_launch: occupancy %d blocks/CU, %d CUs: cannot run\n", per_cu, cus); grid = -1; return; }
        grid = 256;
    }
    if (grid < 0) return;
    Args a{};
    for (int i = 0; i < 17; ++i) a.in[i] = (const float*)d_in[i];
    a.out = (float*)d_out; a.ws = (unsigned char*)d_ws;
#if MK_ONE_LAUNCH
    a.ph_lo = 0; a.ph_hi = N_PHASES;
    void* kargs[] = {&a};
    hipError_t e = hipLaunchCooperativeKernel((const void*)mega<0, N_PHASES>, dim3(grid), dim3(NTHREADS), kargs, LDS_BYTES, stream);
    if (e != hipSuccess) fprintf(stderr, "kernel_launch: cooperative launch failed: %s\n", hipGetErrorString(e));
#else
    launch_all(a, grid, stream, std::make_integer_sequence<int, N_PHASES>{});
#endif
}
```

```cpp
#include <hip/hip_runtime.h>
#include <hip/hip_cooperative_groups.h>
#include <cstdio>
#include <cstdint>
namespace cg = cooperative_groups;
#define MK_ONE_LAUNCH 1
#define FAST_C 1
#define FAST_A 1
#define FAST_B 1
namespace pg8 {
#define PG8_LAS __attribute__((address_space(3)))
typedef unsigned short bf16_t;
typedef short bf16x8 __attribute__((ext_vector_type(8)));
typedef _Float16 half8 __attribute__((ext_vector_type(8)));
typedef float f32x4 __attribute__((ext_vector_type(4)));
typedef unsigned u32x4 __attribute__((ext_vector_type(4)));
constexpr int BM = 256, BK = 64, HALF = 128, HTB = HALF * BK * 2  , STAGE_BYTES = 8 * HTB, NXCD = 8, WGM = 8;

__host__ __device__ __forceinline__ int lds_byte(int r, int c) { const int st = (r >> 4) * 2 + (c >> 5), rr = r & 15, cc = c & 31, ob = rr * 64 + cc * 2; return st * 1024 + (ob ^ (((ob >> 9) & 1) << 5)); }
__host__ __device__ __forceinline__ void stage_rc(int b, int& R, int& C) { const int st = b / 1024, sb = b % 1024, swz = sb ^ (((sb >> 9) & 1) << 5); R = (st >> 1) * 16 + swz / 64; C = (st & 1) * 32 + (swz % 64) / 2; }
__host__ __device__ __forceinline__ int perm32(int rho) { const int n = rho >> 4, i = rho & 15; return 8 * (i >> 2) + 4 * n + (i & 3); }

struct Unit { int pm, pn; };
struct Gemm { const bf16_t* A; const bf16_t* Bt; int M, N, K; };

struct StaticOrder {
    int nM, nN, nwg, G, c;
    __host__ __device__ void init(int M, int N, int G_, int c_) { nM = M / BM; nN = N / BM; nwg = nM * nN; G = G_; c = c_; }
    __host__ __device__ bool next(int i, Unit& u) const {
        const long L = (long)i * G + c; if (L >= nwg) return false;
        int wgid = (int)L; { const int q = nwg / NXCD, r = nwg % NXCD, xcd = wgid % NXCD, off = wgid / NXCD; wgid = (xcd < r ? xcd * (q + 1) : r * (q + 1) + (xcd - r) * q) + off; }
        const int nig = WGM * nN, gid = wgid / nig, fm = gid * WGM, gsz = (nM - fm) < WGM ? (nM - fm) : WGM;
        u.pm = fm + ((wgid % nig) % gsz); u.pn = (wgid % nig) / gsz; return true;
    }
    __device__ __forceinline__ void a_ready(const Unit&) const {}
    __device__ __forceinline__ void done(const Unit&) const {}
};

__device__ __forceinline__ unsigned cvt_pk_bf16(float lo, float hi) { unsigned r; asm volatile("v_cvt_pk_f16_f32 %0, %1, %2" : "=v"(r) : "v"(lo), "v"(hi)); return r; }
typedef float f32x2 __attribute__((ext_vector_type(2)));
__device__ __forceinline__ f32x2 gelu_pk(f32x2 v) {
    const f32x2 av = __builtin_elementwise_abs(v), d = av * 0.2316418882f + 1.0f;
    f32x2 t; t.x = __builtin_amdgcn_rcpf(d.x); t.y = __builtin_amdgcn_rcpf(d.y);
    f32x2 q = t * 0.5307027145f + (-0.7265760135f); q = q * t + 0.7107068705f; q = q * t + (-0.142248368f); q = q * t + 0.127414796f; q = q * t;
    const f32x2 s = (v * v) * (-0.72134752044f);
    f32x2 e; e.x = __builtin_amdgcn_exp2f(s.x); e.y = __builtin_amdgcn_exp2f(s.y);
    const f32x2 m = v * (q * e), r = v - m;
    f32x2 o; o.x = v.x < 0.f ? m.x : r.x; o.y = v.y < 0.f ? m.y : r.y; return o;
}

template <int ACT  > struct EpiBf16 {
    static constexpr bool PERM = true, AFTER_DRAIN = false; static_assert(ACT == 0 || ACT == 1, "EpiBf16: ACT is 0 (none) or 1 (gelu_pk)");
    bf16_t* O; int ldc; const float* bias; int split_cols; size_t split_stride; float scale0;
    __device__ __forceinline__ void operator()(const f32x4 (&acc)[2][2][4][2], const Unit& u, int wr, int wc, int fr, int fq) const {
        const int row0 = u.pm * BM + wr * 64 + fr; int colt = u.pn * BM; bf16_t* base = O;
        float sc = 1.f; if (split_cols) { const int t = colt / split_cols; base += (size_t)t * split_stride; colt -= t * split_cols; if (t == 0) sc = scale0; }
        const int col0 = colt + wc * 32 + 8 * fq, bcol0 = u.pn * BM + wc * 32 + 8 * fq;
        f32x4 bv[2][2];
#pragma unroll
        for (int bj = 0; bj < 2; ++bj)
#pragma unroll
            for (int n = 0; n < 2; ++n) bv[bj][n] = bias ? *(const f32x4*)(bias + bcol0 + bj * HALF + 4 * n) : (f32x4){0.f, 0.f, 0.f, 0.f};
#pragma unroll
        for (int ai = 0; ai < 2; ++ai)
#pragma unroll
            for (int m = 0; m < 4; ++m) { bf16_t* rowp = base + (size_t)(row0 + ai * HALF + m * 16) * ldc + col0;
#pragma unroll
                for (int bj = 0; bj < 2; ++bj) { f32x4 v0 = acc[ai][bj][m][0] + bv[bj][0], v1 = acc[ai][bj][m][1] + bv[bj][1];
                    if (ACT == 1) { f32x2 a = gelu_pk((f32x2){v0[0], v0[1]}), b = gelu_pk((f32x2){v0[2], v0[3]}), c = gelu_pk((f32x2){v1[0], v1[1]}), d = gelu_pk((f32x2){v1[2], v1[3]});
                        v0 = (f32x4){a.x, a.y, b.x, b.y}; v1 = (f32x4){c.x, c.y, d.x, d.y}; }
                    v0 = v0 * sc; v1 = v1 * sc; u32x4 w; w.x = cvt_pk_bf16(v0[0], v0[1]); w.y = cvt_pk_bf16(v0[2], v0[3]); w.z = cvt_pk_bf16(v1[0], v1[1]); w.w = cvt_pk_bf16(v1[2], v1[3]);
                    *(u32x4*)(rowp + bj * HALF) = w; } }
    }
};

struct PanelStats {
    unsigned* xbuf;
    unsigned* cnt;
    unsigned* tmo;
    int ntn; float eps;
    unsigned code;
    __device__ __forceinline__ bool run(const f32x4 (&v)[2][2][4][2], const Unit& u, int wr, int wc, int fr, int fq, PG8_LAS unsigned char* lds, int wid, int lane) const {
        typedef float f32x2v __attribute__((ext_vector_type(2)));
        PG8_LAS f32x2v* P = (PG8_LAS f32x2v*)lds;
        PG8_LAS f32x2v* S = (PG8_LAS f32x2v*)(lds + 8192);
        PG8_LAS unsigned* flag = (PG8_LAS unsigned*)(lds + 8192 + 2048);
#pragma unroll
        for (int ai = 0; ai < 2; ++ai)
#pragma unroll
            for (int m = 0; m < 4; ++m) {
                float s = 0.f;
#pragma unroll
                for (int bj = 0; bj < 2; ++bj)
#pragma unroll
                    for (int n = 0; n < 2; ++n) { const f32x4 x = v[ai][bj][m][n]; s += (x[0] + x[1]) + (x[2] + x[3]); }
                s += __shfl_xor(s, 16); s += __shfl_xor(s, 32);
                const float mw = s * (1.0f / 64.0f); float q = 0.f;
#pragma unroll
                for (int bj = 0; bj < 2; ++bj)
#pragma unroll
                    for (int n = 0; n < 2; ++n) { const f32x4 d = v[ai][bj][m][n] - mw; q += (d[0] * d[0] + d[1] * d[1]) + (d[2] * d[2] + d[3] * d[3]); }
                q += __shfl_xor(q, 16); q += __shfl_xor(q, 32);
                if (fq == 0) P[(ai * HALF + wr * 64 + m * 16 + fr) * 4 + wc] = (f32x2v){mw, q};
            }
        asm volatile("s_waitcnt lgkmcnt(0)" ::: "memory"); __builtin_amdgcn_s_barrier(); asm volatile("" ::: "memory");
#if defined(BROKEN_EXCHANGE_NO_WAIT)
#warning BROKEN CONTROL BUILD: the row-statistics exchange does not wait; results are wrong by design
        if (blockIdx.x >= 64) { const long long t0_ = clock64(); while (clock64() - t0_ < 60000) __builtin_amdgcn_s_sleep(8); }
#endif
        const int row = wid * 32 + (lane & 31);
        if (lane < 32) {
            const f32x2v a = P[row * 4 + 0], b = P[row * 4 + 1], c = P[row * 4 + 2], d = P[row * 4 + 3];
            const float mt = (a.x + b.x + c.x + d.x) * 0.25f;
            const float da = a.x - mt, db = b.x - mt, dc = c.x - mt, dd = d.x - mt;
            const float m2 = (a.y + b.y) + (c.y + d.y) + 64.0f * ((da * da + db * db) + (dc * dc + dd * dd));
            unsigned long long* slot = (unsigned long long*)xbuf + ((size_t)(u.pm * BM + row) * 4 + u.pn);
            __hip_atomic_store(slot, ((unsigned long long)__float_as_uint(m2) << 32) | __float_as_uint(mt), __ATOMIC_RELAXED, __HIP_MEMORY_SCOPE_AGENT);
        }
        asm volatile("s_waitcnt vmcnt(0)" ::: "memory");
        if (lane == 0) __hip_atomic_fetch_add(cnt + 64 * u.pm, 1u, __ATOMIC_RELAXED, __HIP_MEMORY_SCOPE_AGENT);
        if (wid == 0) {
            bool dead = false; const unsigned long long t0 = __builtin_amdgcn_s_memrealtime(); const unsigned want = 8u * (unsigned)ntn;
            for (;;) {
#if defined(BROKEN_EXCHANGE_NO_WAIT)
                break;
#endif
                if ((unsigned)__builtin_amdgcn_readfirstlane(__hip_atomic_load(cnt + 64 * u.pm, __ATOMIC_RELAXED, __HIP_MEMORY_SCOPE_AGENT)) >= want) break;
                if (__builtin_amdgcn_s_memrealtime() - t0 > 2000000ull) {
                    if (lane == 0) { unsigned expect = 0u; __hip_atomic_compare_exchange_strong(tmo + 1, &expect, code | (unsigned)(u.pm & 0xff), __ATOMIC_RELAXED, __ATOMIC_RELAXED, __HIP_MEMORY_SCOPE_AGENT);
                                     __hip_atomic_store(tmo, 1u, __ATOMIC_RELAXED, __HIP_MEMORY_SCOPE_AGENT); }
                    dead = true; break; }
                __builtin_amdgcn_s_sleep(2);
            }
            __builtin_amdgcn_fence(__ATOMIC_ACQUIRE, "agent");
            if (lane == 0) flag[0] = dead ? 1u : 0u;
        }
        asm volatile("s_waitcnt vmcnt(0) lgkmcnt(0)" ::: "memory"); __builtin_amdgcn_s_barrier(); asm volatile("" ::: "memory");
        const bool bad = flag[0] != 0u;
        if (lane < 32) {
            const unsigned long long* slot = (const unsigned long long*)xbuf + (size_t)(u.pm * BM + row) * 4; float mt[4], m2[4]; float ms = 0.f;
#pragma unroll
            for (int t = 0; t < 4; ++t) { if (t < ntn) { const unsigned long long w = __hip_atomic_load(slot + t, __ATOMIC_RELAXED, __HIP_MEMORY_SCOPE_AGENT); mt[t] = __uint_as_float((unsigned)w); m2[t] = __uint_as_float((unsigned)(w >> 32)); } else { mt[t] = 0.f; m2[t] = 0.f; } ms += mt[t]; }
            const float mean = ms / (float)ntn; float q = 0.f;
#pragma unroll
            for (int t = 0; t < 4; ++t) if (t < ntn) { const float dm = mt[t] - mean; q += m2[t] + 256.0f * dm * dm; }
            S[row] = (f32x2v){mean, 1.0f / sqrtf(q / (256.0f * (float)ntn) + eps)};
        }
        asm volatile("s_waitcnt lgkmcnt(0)" ::: "memory"); __builtin_amdgcn_s_barrier(); asm volatile("" ::: "memory");
        return bad;
    }
};
struct EpiLnRes {
    static constexpr bool PERM = false, AFTER_DRAIN = true;
    const float* base; float* out; int ldc; const float* bias; PanelStats st; unsigned poison;
    __device__ __forceinline__ void fused(f32x4 (&acc)[2][2][4][2], const Unit& u, int wr, int wc, int fr, int fq, PG8_LAS unsigned char* lds, int wid, int lane) const {
        typedef float f32x2v __attribute__((ext_vector_type(2)));
        const PG8_LAS f32x2v* S = (const PG8_LAS f32x2v*)(lds + 8192);
        const int col0 = u.pn * BM + wc * 32 + 4 * fq;
#pragma unroll
        for (int bj = 0; bj < 2; ++bj)
#pragma unroll
            for (int n = 0; n < 2; ++n) { const f32x4 bv = bias ? *(const f32x4*)(bias + col0 + bj * HALF + n * 16) : (f32x4){0.f, 0.f, 0.f, 0.f};
#pragma unroll
                for (int ai = 0; ai < 2; ++ai)
#pragma unroll
                    for (int m = 0; m < 4; ++m) acc[ai][bj][m][n] += bv; }
        f32x4 pre[4][2][2];
#pragma unroll
        for (int m = 0; m < 4; ++m) { const size_t off = (size_t)(u.pm * BM + wr * 64 + m * 16 + fr) * ldc + col0;
#pragma unroll
            for (int bj = 0; bj < 2; ++bj)
#pragma unroll
                for (int n = 0; n < 2; ++n) pre[m][bj][n] = *(const f32x4*)(base + off + bj * HALF + n * 16); }
        const bool bad = st.run(acc, u, wr, wc, fr, fq, lds, wid, lane) || poison != 0u;
        const float qnan = __builtin_nanf("");
#pragma unroll
        for (int ai = 0; ai < 2; ++ai)
#pragma unroll
            for (int m = 0; m < 4; ++m) { const int r = ai * HALF + wr * 64 + m * 16 + fr; const f32x2v sr = S[r]; const size_t off = (size_t)(u.pm * BM + r) * ldc + col0;
#pragma unroll
                for (int bj = 0; bj < 2; ++bj)
#pragma unroll
                    for (int n = 0; n < 2; ++n) { const f32x4 bs = ai == 0 ? pre[m][bj][n] : *(const f32x4*)(base + off + bj * HALF + n * 16); f32x4 o = bs + (acc[ai][bj][m][n] - sr.x) * sr.y;
                        if (bad) o = (f32x4){qnan, qnan, qnan, qnan}; *(f32x4*)(out + off + bj * HALF + n * 16) = o; }
                if (m & 1) asm volatile("" ::: "memory"); }
    }
};
struct EpiLnResLn {
    static constexpr bool PERM = false, AFTER_DRAIN = true;
    const float* base; float* out; bf16_t* xn; int ldc; const float* bias; PanelStats st1, st2; unsigned poison;
    __device__ __forceinline__ void fused(f32x4 (&acc)[2][2][4][2], const Unit& u, int wr, int wc, int fr, int fq, PG8_LAS unsigned char* lds, int wid, int lane) const {
        typedef float f32x2v __attribute__((ext_vector_type(2))); typedef unsigned u32x2v __attribute__((ext_vector_type(2)));
        const PG8_LAS f32x2v* S = (const PG8_LAS f32x2v*)(lds + 8192);
        const int col0 = u.pn * BM + wc * 32 + 4 * fq;
#pragma unroll
        for (int bj = 0; bj < 2; ++bj)
#pragma unroll
            for (int n = 0; n < 2; ++n) { const f32x4 bv = bias ? *(const f32x4*)(bias + col0 + bj * HALF + n * 16) : (f32x4){0.f, 0.f, 0.f, 0.f};
#pragma unroll
                for (int ai = 0; ai < 2; ++ai)
#pragma unroll
                    for (int m = 0; m < 4; ++m) acc[ai][bj][m][n] += bv; }
        bool bad = st1.run(acc, u, wr, wc, fr, fq, lds, wid, lane) || poison != 0u;
        const float qnan = __builtin_nanf("");
#pragma unroll
        for (int ai = 0; ai < 2; ++ai)
#pragma unroll
            for (int m = 0; m < 4; ++m) { const int r = ai * HALF + wr * 64 + m * 16 + fr; const f32x2v sr = S[r]; const size_t off = (size_t)(u.pm * BM + r) * ldc + col0;
#pragma unroll
                for (int bj = 0; bj < 2; ++bj)
#pragma unroll
                    for (int n = 0; n < 2; ++n) { const f32x4 bs = *(const f32x4*)(base + off + bj * HALF + n * 16); acc[ai][bj][m][n] = bs + (acc[ai][bj][m][n] - sr.x) * sr.y; }
                asm volatile("" : "+v"(acc[ai][0][m][0]), "+v"(acc[ai][0][m][1]), "+v"(acc[ai][1][m][0]), "+v"(acc[ai][1][m][1]));
                if (m & 1) asm volatile("" ::: "memory"); }
        const bool bad1 = bad;
        bad = st2.run(acc, u, wr, wc, fr, fq, lds, wid, lane) || bad;
#pragma unroll
        for (int ai = 0; ai < 2; ++ai)
#pragma unroll
            for (int m = 0; m < 4; ++m) { const int r = ai * HALF + wr * 64 + m * 16 + fr; const f32x2v sr = S[r]; const size_t off = (size_t)(u.pm * BM + r) * ldc + col0;
#pragma unroll
                for (int bj = 0; bj < 2; ++bj)
#pragma unroll
                    for (int n = 0; n < 2; ++n) { const f32x4 x1 = acc[ai][bj][m][n]; *(f32x4*)(out + off + bj * HALF + n * 16) = bad1 ? (f32x4){qnan, qnan, qnan, qnan} : x1;
                        const f32x4 o = (x1 - sr.x) * sr.y; u32x2v w; w.x = cvt_pk_bf16(o[0], o[1]); w.y = cvt_pk_bf16(o[2], o[3]);
                        if (bad) { w.x = 0x7fc07fc0u; w.y = 0x7fc07fc0u; } *(u32x2v*)(xn + off + bj * HALF + n * 16) = w; }
                asm volatile("" ::: "memory"); }
    }
};

template <class Epi, class Sched, bool ALIGN_EPI = false, bool SP2 = false>
__device__ __forceinline__ void gemm_phase(PG8_LAS unsigned char* lds, const Gemm g, const Sched& S, const Epi& E) {
    int tid_ = threadIdx.x; asm volatile("" : "+v"(tid_));
    const int tid = tid_, wid = __builtin_amdgcn_readfirstlane(tid >> 6), lane = tid & 63, wr = wid >> 2, wc = wid & 3, fr = lane & 15, fq = lane >> 4;
    const int K = g.K, nt = K / BK;
    unsigned voffA[2], voffB[2];
#pragma unroll
    for (int i = 0; i < 2; ++i) { int R, C; stage_rc(tid * 16 + i * 8192, R, C); const int Rb = Epi::PERM ? ((R & ~31) + perm32(R & 31)) : R;
        voffA[i] = (unsigned)(R * K + C) * 2u; voffB[i] = (unsigned)(Rb * K + C) * 2u; }
    const size_t kstep = (size_t)(BK * 2);
    const size_t hstep = (size_t)HALF * K * 2;
    const size_t tstep = 2 * hstep;
    const unsigned ldsw = (unsigned)wid * 1024u;
    const int aoff = lds_byte(wr * 64 + fr, fq * 8), boff = lds_byte(wc * 32 + fr, fq * 8);
#define PG8_SA(b, h) (((b) * 2 + (h)) * HTB)
#define PG8_SB(b, h) ((4 + (b) * 2 + (h)) * HTB)
#define PG8_STAGE(bufoff, gbase, voff) do { _Pragma("unroll") for (int _i = 0; _i < 2; ++_i) \
        __builtin_amdgcn_global_load_lds((const unsigned*)((const char*)(gbase) + (voff)[_i]), (PG8_LAS unsigned*)(lds + (bufoff) + ldsw + _i * 8192), 16, 0, 0); } while (0)
#define PG8_LDA(dst, b, h) do { _Pragma("unroll") for (int m = 0; m < 4; ++m) _Pragma("unroll") for (int k = 0; k < 2; ++k) dst[m][k] = *(const PG8_LAS bf16x8*)(lds + PG8_SA(b, h) + aoff + m * 2048 + k * 1024); } while (0)
#define PG8_LDB(dst, b, h) do { _Pragma("unroll") for (int n = 0; n < 2; ++n) _Pragma("unroll") for (int k = 0; k < 2; ++k) dst[n][k] = *(const PG8_LAS bf16x8*)(lds + PG8_SB(b, h) + boff + n * 2048 + k * 1024); } while (0)
#define PG8_MMA(ai, bj, At, Bt) do { __builtin_amdgcn_s_setprio(1); _Pragma("unroll") for (int m = 0; m < 4; ++m) _Pragma("unroll") for (int n = 0; n < 2; ++n) _Pragma("unroll") for (int k = 0; k < 2; ++k) \
        acc[ai][bj][m][n] = __builtin_amdgcn_mfma_f32_16x16x32_f16(__builtin_bit_cast(half8, Bt[n][k]), __builtin_bit_cast(half8, At[m][k]), acc[ai][bj][m][n], 0, 0, 0); __builtin_amdgcn_s_setprio(0); } while (0)
#define PG8_WAIT_V(n) asm volatile("s_waitcnt vmcnt(" #n ")" ::: "memory")
#define PG8_WAIT_L(n) asm volatile("s_waitcnt lgkmcnt(" #n ")" ::: "memory")
#define PG8_BAR __builtin_amdgcn_s_barrier()
#define PG8_SCHED __builtin_amdgcn_sched_barrier(0)
    Unit cur, nxt; int ui = 0;
    if (!S.next(0, cur)) return;
    f32x4 acc[2][2][4][2];
#pragma unroll
    for (int a = 0; a < 2; ++a)
#pragma unroll
        for (int b = 0; b < 2; ++b)
#pragma unroll
            for (int m = 0; m < 4; ++m)
#pragma unroll
                for (int n = 0; n < 2; ++n) acc[a][b][m][n] = (f32x4){0.f, 0.f, 0.f, 0.f};
    bf16x8 At[4][2], B0[2][2], B1[2][2];
    const char* cA = (const char*)g.A + (size_t)cur.pm * tstep; const char* cB = (const char*)g.Bt + (size_t)cur.pn * tstep;
    S.a_ready(cur);
    if constexpr (SP2) {
        PG8_STAGE(PG8_SB(0, 0), cB, voffB); PG8_STAGE(PG8_SB(0, 1), cB + hstep, voffB); PG8_STAGE(PG8_SA(0, 0), cA, voffA); PG8_STAGE(PG8_SA(0, 1), cA + hstep, voffA);
        if (wr == 1) PG8_BAR;
        PG8_WAIT_V(2); PG8_BAR;
        PG8_STAGE(PG8_SB(1, 0), cB + kstep, voffB); PG8_STAGE(PG8_SA(1, 0), cA + kstep, voffA); PG8_STAGE(PG8_SB(1, 1), cB + hstep + kstep, voffB);
        PG8_WAIT_V(6); PG8_BAR;
    } else {
        PG8_STAGE(PG8_SB(0, 0), cB, voffB); PG8_STAGE(PG8_SA(0, 0), cA, voffA); PG8_STAGE(PG8_SB(0, 1), cB + hstep, voffB); PG8_STAGE(PG8_SA(0, 1), cA + hstep, voffA);
        if (wr == 1) PG8_BAR;
        PG8_WAIT_V(4); PG8_BAR;
        PG8_STAGE(PG8_SB(1, 0), cB + kstep, voffB); PG8_STAGE(PG8_SA(1, 0), cA + kstep, voffA); PG8_STAGE(PG8_SB(1, 1), cB + hstep + kstep, voffB);
        PG8_WAIT_V(6); PG8_BAR;
    }
    for (;;) {
        const bool has_next = S.next(ui + 1, nxt);
        const char* nA = has_next ? (const char*)g.A + (size_t)nxt.pm * tstep : cA; const char* nB = has_next ? (const char*)g.Bt + (size_t)nxt.pn * tstep : cB;
        for (int t = 0; t < nt; t += 2) {
            const bool last = (t == nt - 2);
            const char* a1 = cA + (size_t)(t + 1) * kstep;
            const char* a2 = last ? nA : cA + (size_t)(t + 2) * kstep; const char* b2 = last ? nB : cB + (size_t)(t + 2) * kstep;
            const char* a3 = a2 + kstep; const char* b3 = b2 + kstep;
            if (last && has_next) S.a_ready(nxt);
            if constexpr (SP2) {
            PG8_LDB(B0, 0, 0); PG8_LDB(B1, 0, 1); PG8_SCHED; PG8_LDA(At, 0, 0); PG8_STAGE(PG8_SA(1, 1), a1 + hstep, voffA);
            PG8_WAIT_V(8); PG8_WAIT_L(0); PG8_BAR; PG8_MMA(0, 0, At, B0); PG8_MMA(0, 1, At, B1); PG8_BAR; PG8_SCHED;
            PG8_LDA(At, 0, 1); PG8_STAGE(PG8_SB(0, 0), b2, voffB); PG8_STAGE(PG8_SB(0, 1), b2 + hstep, voffB); PG8_STAGE(PG8_SA(0, 0), a2, voffA);
            PG8_WAIT_V(8); PG8_WAIT_L(0); PG8_BAR; PG8_MMA(1, 0, At, B0); PG8_MMA(1, 1, At, B1); PG8_BAR; PG8_SCHED;
            PG8_LDB(B0, 1, 0); PG8_LDB(B1, 1, 1); PG8_SCHED; PG8_LDA(At, 1, 0); PG8_STAGE(PG8_SA(0, 1), a2 + hstep, voffA);
            PG8_WAIT_V(8); PG8_WAIT_L(0); PG8_BAR; PG8_MMA(0, 0, At, B0); PG8_MMA(0, 1, At, B1); PG8_BAR; PG8_SCHED;
            PG8_LDA(At, 1, 1); PG8_STAGE(PG8_SB(1, 0), b3, voffB); PG8_STAGE(PG8_SB(1, 1), b3 + hstep, voffB); PG8_STAGE(PG8_SA(1, 0), a3, voffA);
            PG8_WAIT_V(8); PG8_WAIT_L(0); PG8_BAR; PG8_MMA(1, 0, At, B0); PG8_MMA(1, 1, At, B1); PG8_BAR; PG8_SCHED;
            } else {
            PG8_LDB(B0, 0, 0); PG8_SCHED; PG8_LDA(At, 0, 0); PG8_STAGE(PG8_SA(1, 1), a1 + hstep, voffA);
            PG8_WAIT_L(8); PG8_BAR; PG8_WAIT_L(0); PG8_MMA(0, 0, At, B0); PG8_BAR; PG8_SCHED;
            PG8_LDB(B1, 0, 1); PG8_STAGE(PG8_SB(0, 0), b2, voffB);
            PG8_BAR; PG8_WAIT_L(0); PG8_MMA(0, 1, At, B1); PG8_BAR;
            PG8_LDA(At, 0, 1); PG8_STAGE(PG8_SA(0, 0), a2, voffA);
            PG8_BAR; PG8_WAIT_L(0); PG8_MMA(1, 0, At, B0); PG8_BAR; PG8_SCHED;
            PG8_STAGE(PG8_SB(0, 1), b2 + hstep, voffB);
            PG8_WAIT_V(6); PG8_BAR; PG8_MMA(1, 1, At, B1); PG8_BAR;
            PG8_LDB(B0, 1, 0); PG8_SCHED; PG8_LDA(At, 1, 0); PG8_STAGE(PG8_SA(0, 1), a2 + hstep, voffA);
            PG8_WAIT_L(8); PG8_BAR; PG8_WAIT_L(0); PG8_MMA(0, 0, At, B0); PG8_BAR; PG8_SCHED;
            PG8_LDB(B1, 1, 1); PG8_STAGE(PG8_SB(1, 0), b3, voffB);
            PG8_BAR; PG8_WAIT_L(0); PG8_MMA(0, 1, At, B1); PG8_BAR;
            PG8_LDA(At, 1, 1); PG8_STAGE(PG8_SA(1, 0), a3, voffA);
            PG8_BAR; PG8_WAIT_L(0); PG8_MMA(1, 0, At, B0); PG8_BAR; PG8_SCHED;
            PG8_STAGE(PG8_SB(1, 1), b3 + hstep, voffB);
            PG8_WAIT_V(6); PG8_BAR; PG8_MMA(1, 1, At, B1); PG8_BAR;
            }
        }
        if constexpr (ALIGN_EPI) { if (wr == 0) PG8_BAR; }
        if constexpr (!Epi::AFTER_DRAIN) { E(acc, cur, wr, wc, fr, fq); S.done(cur); }
        if (!has_next) break;
#pragma unroll
        for (int a = 0; a < 2; ++a)
#pragma unroll
            for (int b = 0; b < 2; ++b)
#pragma unroll
                for (int m = 0; m < 4; ++m)
#pragma unroll
                    for (int n = 0; n < 2; ++n) acc[a][b][m][n] = (f32x4){0.f, 0.f, 0.f, 0.f};
        cur = nxt; cA = nA; cB = nB; ++ui;
        if constexpr (ALIGN_EPI) { if (wr == 1) PG8_BAR; }
    }
    PG8_WAIT_V(0);
    if constexpr (!ALIGN_EPI) { if (wr == 0) PG8_BAR; }
    PG8_BAR;
    if constexpr (Epi::AFTER_DRAIN) { E.fused(acc, cur, wr, wc, fr, fq, lds, wid, lane); S.done(cur); }
#undef PG8_SA
#undef PG8_SB
#undef PG8_STAGE
#undef PG8_LDA
#undef PG8_LDB
#undef PG8_MMA
#undef PG8_WAIT_V
#undef PG8_WAIT_L
#undef PG8_BAR
#undef PG8_SCHED
}
}

#define LAS __attribute__((address_space(3)))
typedef unsigned short bf16;
typedef float f32x4 __attribute__((ext_vector_type(4)));
typedef unsigned u32x4 __attribute__((ext_vector_type(4)));
typedef unsigned u32x2 __attribute__((ext_vector_type(2)));
constexpr int D = 1024, NB = 16, SEQ = 4096, M = NB * SEQ, CH = 64, NCHUNK = SEQ / CH;
constexpr int DIN = 3740, NP = 3840;
constexpr float LN_EPS = 1e-5f, NORM_EPS = 1e-6f, ALPHA = 1.41421356237f;
constexpr int A_BASE = 0;
constexpr int C_BASE = 1024;
constexpr int B_BASE = 2560;
constexpr int LR_COL = 3712, AC_COL = 3728, BC_COL = 3734;
__host__ __device__ inline int old_col(int n) {
    if (n < 1024) { const int h = n >> 8, r = n & 255, seg = r >> 6, c = r & 63; return seg * 256 + h * 64 + c; }
    if (n < 2560) { const int m = n - 1024, h = m >> 8, r = m & 255, seg = r >> 6, c = r & 63; return seg < 3 ? 2192 + seg * 384 + h * 64 + c : 3356 + h * 64 + c; }
    if (n < 3712) { const int m = n - 2560, h = m / 288, r = m % 288;
        if (r < 48) return 1024 + h * 48 + r; if (r < 96) return 1216 + h * 48 + (r - 48); if (r < 192) return 1408 + h * 96 + (r - 96); return 1808 + h * 96 + (r - 192); }
    if (n < 3728) return 1792 + (n - 3712);
    if (n < 3734) return 3344 + (n - 3728);
    if (n < 3740) return 3350 + (n - 3734);
    return -1;
}
constexpr size_t MiB = 1u << 20;
constexpr size_t WS_CTL = 0, WS_WIN = 1 * MiB, WS_WOUT = 16 * MiB, WS_MOD = 20 * MiB, WS_LB = 21 * MiB;
constexpr size_t WS_HY = 32 * MiB, WS_X1 = 160 * MiB, WS_PROJ = 416 * MiB, WS_END = 896 * MiB;
constexpr int LDS_BYTES = 147456, MISC_OFF = LDS_BYTES - 64;
constexpr int CW_BAR = 1024; constexpr size_t CTL_ZERO_BYTES = 65536;
constexpr int NTHREADS = 512;

struct Args { const float* in[17]; float* out; unsigned char* ws; int ph_lo, ph_hi; };
enum { I_X = 0, I_C, I_WIN, I_WOUT, I_ADAW, I_ADAB, I_LNG, I_LNB, I_LBL, I_WGK, I_BGK, I_CONV, I_ALOG, I_DTB, I_GA, I_GB, I_GC };

__device__ __forceinline__ unsigned f2bf(float f) { return (unsigned)__builtin_bit_cast(unsigned short, (_Float16)f); }
__device__ __forceinline__ unsigned pk2(float lo, float hi) { typedef _Float16 h2 __attribute__((ext_vector_type(2))); h2 v; v.x = (_Float16)lo; v.y = (_Float16)hi; return __builtin_bit_cast(unsigned, v); }
__device__ __forceinline__ float bf2f(bf16 b) { return (float)__builtin_bit_cast(_Float16, b); }
__device__ __forceinline__ float wave_sum(float v) {
#pragma unroll
    for (int o = 1; o < 64; o <<= 1) v += __shfl_xor(v, o);
    return v;
}
__device__ __forceinline__ float sigmoidf_(float x) { return 1.0f / (1.0f + __expf(-x)); }
__device__ __forceinline__ float siluf_(float x) { return x / (1.0f + __expf(-x)); }
__device__ __forceinline__ float softplusf_(float x) { return x > 20.f ? x : log1pf(__expf(x)); }
__device__ __forceinline__ float logsigmoidf_(float x) { return x < 0.f ? x - log1pf(__expf(x)) : -log1pf(__expf(-x)); }

__device__ __forceinline__ void p0_prep(const Args& a, unsigned char* lds_g) {
    int tid = threadIdx.x; asm volatile("" : "+v"(tid)); const int G = gridDim.x, bid = blockIdx.x;
    unsigned char* ws = a.ws;
    if (bid < 192) {
        float* cact = (float*)lds_g;
        float* part = cact + 16 * 1024;
        const float* c = a.in[I_C];
        for (int i = tid; i < 16 * 1024; i += NTHREADS) cact[i] = siluf_(c[i]);
        __syncthreads();
        const int l = bid / 96, j0 = (bid % 96) * 32, col = tid & 31, ks = tid >> 5;
        const float* W = a.in[I_ADAW] + (size_t)l * 1024 * 3072 + j0 + col;
        float acc[16];
#pragma unroll
        for (int b = 0; b < 16; ++b) acc[b] = 0.f;
        for (int k = ks * 64; k < ks * 64 + 64; ++k) {
            const float w = W[(size_t)k * 3072];
#pragma unroll
            for (int b = 0; b < 16; ++b) acc[b] += cact[b * 1024 + k] * w;
        }
#pragma unroll
        for (int b = 0; b < 16; ++b) part[(ks * 16 + b) * 32 + col] = acc[b];
        __syncthreads();
        { const int b = tid >> 5; float s = 0.f;
#pragma unroll
          for (int k2 = 0; k2 < 16; ++k2) s += part[(k2 * 16 + b) * 32 + col];
          s += a.in[I_ADAB][l * 3072 + j0 + col];
          ((float*)(ws + WS_MOD))[(size_t)(l * 16 + b) * 3072 + j0 + col] = s; }
        __syncthreads();
    }
    if (bid == 255) {
        const int l = tid >> 8, cc = tid & 255;
        const float l0 = a.in[I_LBL][cc], l1 = a.in[I_LBL][256 + cc];
        ((float*)(ws + WS_LB))[tid] = l == 0 ? 0.f : 1.0f / (1.0f + __expf(l0 - l1));
    }
    {
        const size_t gt = (size_t)bid * NTHREADS + tid, GT = (size_t)G * NTHREADS;
        bf16* WinT = (bf16*)(ws + WS_WIN);
        for (size_t idx = gt; idx < (size_t)2 * 128 * NP; idx += GT) {
            const int n = (int)(idx % NP), kb = (int)((idx / NP) % 128), l = (int)(idx / ((size_t)NP * 128));
            const int oc = old_col(n);
            float v[8];
#pragma unroll
            for (int j = 0; j < 8; ++j) v[j] = oc >= 0 ? a.in[I_WIN][((size_t)l * 1024 + kb * 8 + j) * DIN + oc] : 0.f;
            u32x4 o; o.x = pk2(v[0], v[1]); o.y = pk2(v[2], v[3]); o.z = pk2(v[4], v[5]); o.w = pk2(v[6], v[7]);
            *(u32x4*)(WinT + ((size_t)l * NP + n) * 1024 + kb * 8) = o;
        }
        bf16* WoutT = (bf16*)(ws + WS_WOUT);
        for (size_t idx = gt; idx < (size_t)2 * 128 * 1024; idx += GT) {
            const int n = (int)(idx % 1024), kb = (int)((idx / 1024) % 128), l = (int)(idx / ((size_t)1024 * 128));
            float v[8];
#pragma unroll
            for (int j = 0; j < 8; ++j) v[j] = a.in[I_WOUT][((size_t)l * 1024 + kb * 8 + j) * 1024 + n];
            u32x4 o; o.x = pk2(v[0], v[1]); o.y = pk2(v[2], v[3]); o.z = pk2(v[4], v[5]); o.w = pk2(v[6], v[7]);
            *(u32x4*)(WoutT + ((size_t)l * 1024 + n) * 1024 + kb * 8) = o;
        }
    }
}

template <int MODE>
__device__ __forceinline__ void ln_rows(const float* src, float* xo, bf16* hout, const float* lng, const float* lnb, const float* mod  ) {
    int tid = threadIdx.x; asm volatile("" : "+v"(tid));
    const int lane = tid & 63, wave = tid >> 6;
    const int gw = blockIdx.x * 8 + wave, NGW = gridDim.x * 8;
    for (int m = gw; m < M; m += NGW) {
        const f32x4* xr = (const f32x4*)(src + (size_t)m * D) + lane;
        f32x4 v[4]; float s = 0.f;
#pragma unroll
        for (int j = 0; j < 4; ++j) { v[j] = xr[64 * j]; s += (v[j].x + v[j].y) + (v[j].z + v[j].w); }
        float mean = wave_sum(s) * (1.f / D); float s2 = 0.f;
#pragma unroll
        for (int j = 0; j < 4; ++j) { v[j] = v[j] - mean; s2 += (v[j].x * v[j].x + v[j].y * v[j].y) + (v[j].z * v[j].z + v[j].w * v[j].w); }
        float rstd = 1.f / sqrtf(wave_sum(s2) * (1.f / D) + LN_EPS);
        const int b = m >> 12;
        if (MODE == 1) {
            s = 0.f;
#pragma unroll
            for (int j = 0; j < 4; ++j) { const f32x4 g = *((const f32x4*)lng + lane + 64 * j), bb = *((const f32x4*)lnb + lane + 64 * j);
                v[j] = v[j] * rstd * g + bb; *((f32x4*)(xo + (size_t)m * D) + lane + 64 * j) = v[j]; s += (v[j].x + v[j].y) + (v[j].z + v[j].w); }
            if (!hout) continue;
            mean = wave_sum(s) * (1.f / D); s2 = 0.f;
#pragma unroll
            for (int j = 0; j < 4; ++j) { v[j] = v[j] - mean; s2 += (v[j].x * v[j].x + v[j].y * v[j].y) + (v[j].z * v[j].z + v[j].w * v[j].w); }
            rstd = 1.f / sqrtf(wave_sum(s2) * (1.f / D) + LN_EPS);
        }
        const float* mb = mod + (size_t)b * 3072;
#pragma unroll
        for (int j = 0; j < 4; ++j) { const f32x4 sh = *((const f32x4*)mb + lane + 64 * j), sc = *((const f32x4*)(mb + 1024) + lane + 64 * j);
            const f32x4 h = v[j] * rstd * (sc + 1.0f) + sh;
            u32x2 w; w.x = pk2(h.x, h.y); w.y = pk2(h.z, h.w);
            *((u32x2*)(hout + (size_t)m * D) + lane + 64 * j) = w; }
    }
}

struct EpiRes {
    static constexpr bool PERM = false, AFTER_DRAIN = false;
    const float* xin; float* res; const float* gate;
    __device__ __forceinline__ void operator()(const pg8::f32x4 (&acc)[2][2][4][2], const pg8::Unit& u, int wr, int wc, int fr, int fq) const {
        const int row0 = u.pm * 256 + wr * 64 + fr, col0 = u.pn * 256 + wc * 32 + 4 * fq;
#pragma unroll
        for (int ai = 0; ai < 2; ++ai)
#pragma unroll
            for (int m = 0; m < 4; ++m) { const int row = row0 + ai * 128 + m * 16; const int b = row >> 12;
#pragma unroll
                for (int bj = 0; bj < 2; ++bj)
#pragma unroll
                    for (int n = 0; n < 2; ++n) { const int col = col0 + bj * 128 + n * 16;
                        const f32x4 g = *(const f32x4*)(gate + (size_t)b * 3072 + col), xv = *(const f32x4*)(xin + (size_t)row * D + col);
                        *(f32x4*)(res + (size_t)row * D + col) = xv * ALPHA + g * acc[ai][bj][m][n]; } }
    }
};

template <int DK, int DV, bool ISA>
__device__ __forceinline__ void mix_gla_base(const Args& a, int layer, int b, int h, float* lds) {
    constexpr int PK = DK + 1, PV = DV + 1;
    float* q = lds; float* k = q + 64 * PK; float* bc = k + 64 * PK; float* v = bc + 64 * PK; float* sc = v + 64 * PV; float* S = sc + 64 * 65; float* o = S + DK * DV; float* rinv = o + 64 * PV;
    int tid0 = threadIdx.x; asm volatile("" : "+v"(tid0));
    const bf16* proj = (const bf16*)(a.ws + WS_PROJ);
    bf16* y = (bf16*)(a.ws + WS_HY);
    const int base = ISA ? A_BASE + 256 * h : B_BASE + 288 * h;
    const int vcol = ISA ? base + 128 : base + 96, zcol = ISA ? base + 192 : base + 192;
    const int ycol = ISA ? 64 * h : 256 + 96 * h;
    const float* gain = ISA ? a.in[I_GA] + layer * 64 : a.in[I_GB] + layer * 96;
    const float* lb = (const float*)(a.ws + WS_LB) + layer * 256 + h * 64;
    const float* wgk = a.in[I_WGK] + (size_t)layer * 16 * 192 + h * 48;
    const float* bgk = a.in[I_BGK] + layer * 192 + h * 48;
    for (int i = tid0; i < DK * DV; i += NTHREADS) S[i] = 0.f;
    for (int n = 0; n < NCHUNK; ++n) {
        int tid = tid0; asm volatile("" : "+v"(tid));
        const size_t t0 = (size_t)b * SEQ + (size_t)n * 64;
        __syncthreads();
        for (int i = tid; i < 64 * DK; i += NTHREADS) { const int t = i / DK, c = i % DK; const bf16* row = proj + (t0 + t) * NP;
            if (ISA) { const float qr = bf2f(row[base + c]), fl = bf2f(row[base + 64 + c]); const float sg = sigmoidf_(fl), lbv = lb[c];
                q[t * PK + c] = siluf_(qr); const float f = lbv + (1.f - lbv) * sg; bc[t * PK + c] = __logf(fmaxf(f, 1e-30f)); k[t * PK + c] = (1.f - lbv) * sigmoidf_(-fl); }
            else { q[t * PK + c] = bf2f(row[base + c]) * 0.14433756729740643f; k[t * PK + c] = bf2f(row[base + 48 + c]);
                float s = bgk[c];
#pragma unroll
                for (int r = 0; r < 16; ++r) s += bf2f(row[LR_COL + r]) * wgk[r * 192 + c];
                bc[t * PK + c] = logsigmoidf_(s) * (1.0f / 16.0f); } }
        for (int i = tid; i < 64 * DV; i += NTHREADS) { const int t = i / DV, c = i % DV; v[t * PV + c] = bf2f(proj[(t0 + t) * NP + vcol + c]); }
        __syncthreads();
        if (tid < DK) { float run = 0.f; for (int t = 0; t < 64; ++t) { run += bc[t * PK + tid]; bc[t * PK + tid] = run; } }
        __syncthreads();
        for (int i = tid; i < 64 * 64; i += NTHREADS) { const int t = i >> 6, s = i & 63; float acc = 0.f;
            if (s <= t) for (int c = 0; c < DK; ++c) acc += q[t * PK + c] * k[s * PK + c] * __expf(bc[t * PK + c] - bc[s * PK + c]);
            sc[t * 65 + s] = acc; }
        __syncthreads();
        for (int i = tid; i < 64 * DV; i += NTHREADS) { const int t = i / DV, c = i % DV; float acc = 0.f;
            for (int s = 0; s <= t; ++s) acc += sc[t * 65 + s] * v[s * PV + c];
            for (int kk = 0; kk < DK; ++kk) acc += q[t * PK + kk] * __expf(bc[t * PK + kk]) * S[kk * DV + c];
            o[t * PV + c] = acc; }
        __syncthreads();
        for (int i = tid; i < DK * DV; i += NTHREADS) { const int kk = i / DV, c = i % DV; const float bl = bc[63 * PK + kk]; float acc = __expf(bl) * S[i];
            for (int s = 0; s < 64; ++s) acc += k[s * PK + kk] * __expf(bl - bc[s * PK + kk]) * v[s * PV + c];
            S[i] = acc; }
        if (tid < 64) { float s2 = 0.f; for (int c = 0; c < DV; ++c) s2 += o[tid * PV + c] * o[tid * PV + c]; rinv[tid] = 1.0f / sqrtf(s2 * (1.0f / DV) + NORM_EPS); }
        __syncthreads();
        for (int i = tid; i < 64 * DV; i += NTHREADS) { const int t = i / DV, c = i % DV; const float z = bf2f(proj[(t0 + t) * NP + zcol + c]);
            y[(t0 + t) * D + ycol + c] = (bf16)f2bf(o[t * PV + c] * rinv[t] * gain[c] * siluf_(z)); }
    }
}
__device__ __forceinline__ void mix_gdn_base(const Args& a, int layer, int b, int h, float* lds) {
    constexpr int P = 65;
    float* q = lds; float* k = q + 64 * P; float* v = k + 64 * P; float* L = v + 64 * P; float* at = L + 64 * P; float* U = at + 64 * P; float* W = U + 64 * P; float* S = W + 64 * P;
    float* bc = S + 64 * 64; float* beta = bc + 64; float* g = beta + 64; float* rinv = g + 64;
    int tid0 = threadIdx.x; asm volatile("" : "+v"(tid0));
    const bf16* proj = (const bf16*)(a.ws + WS_PROJ);
    bf16* y = (bf16*)(a.ws + WS_HY);
    const int base = C_BASE + 256 * h, ycol = 640 + 64 * h;
    const float* gain = a.in[I_GC] + layer * 64;
    const float* cw = a.in[I_CONV] + (size_t)layer * 4 * 1152;
    const float alog = a.in[I_ALOG][layer * 6 + h], dtb = a.in[I_DTB][layer * 6 + h];
    for (int i = tid0; i < 64 * 64; i += NTHREADS) S[i] = 0.f;
    for (int n = 0; n < NCHUNK; ++n) {
        int tid = tid0; asm volatile("" : "+v"(tid));
        const size_t t0 = (size_t)b * SEQ + (size_t)n * 64;
        __syncthreads();
        for (int i = tid; i < 64 * 192; i += NTHREADS) { const int t = i / 192, cc = i % 192, seg = cc >> 6, c = cc & 63; const int ch = seg * 384 + h * 64 + c; float acc = 0.f;
#pragma unroll
            for (int j = 0; j < 4; ++j) { const int p = n * 64 + t - 3 + j; if (p >= 0) acc += cw[j * 1152 + ch] * bf2f(proj[((size_t)b * SEQ + p) * NP + base + seg * 64 + c]); }
            const float r = siluf_(acc); (seg == 0 ? q : seg == 1 ? k : v)[t * P + c] = r; }
        if (tid < 64) { const bf16* row = proj + (t0 + tid) * NP; const float av = bf2f(row[AC_COL + h]), bv = bf2f(row[BC_COL + h]);
            g[tid] = -__expf(alog) * softplusf_(av + dtb); beta[tid] = sigmoidf_(bv); }
        __syncthreads();
        if (tid < 64) { float sq = 0.f, sk = 0.f; for (int c = 0; c < 64; ++c) { sq += q[tid * P + c] * q[tid * P + c]; sk += k[tid * P + c] * k[tid * P + c]; }
            const float nq = 0.125f / sqrtf(sq + NORM_EPS), nk = 1.0f / sqrtf(sk + NORM_EPS);
            for (int c = 0; c < 64; ++c) { q[tid * P + c] *= nq; k[tid * P + c] *= nk; } }
        if (tid == 64) { float run = 0.f; for (int t = 0; t < 64; ++t) { run += g[t]; bc[t] = run; } }
        __syncthreads();
        for (int i = tid; i < 64 * 64; i += NTHREADS) { const int t = i >> 6, s = i & 63; float kk = 0.f, qk = 0.f;
            if (s <= t) { for (int c = 0; c < 64; ++c) { kk += k[t * P + c] * k[s * P + c]; qk += q[t * P + c] * k[s * P + c]; } }
            const float dec = s <= t ? __expf(bc[t] - bc[s]) : 0.f;
            L[t * P + s] = s < t ? beta[t] * kk * dec : 0.f; at[t * P + s] = qk * dec;
            U[t * P + s] = v[t * P + s] * beta[t]; W[t * P + s] = k[t * P + s] * beta[t] * __expf(bc[t]); }
        __syncthreads();
        if (tid < 128) { float* X = (tid < 64 ? U : W); const int c = tid & 63;
            for (int t = 1; t < 64; ++t) { float acc = X[t * P + c]; for (int s = 0; s < t; ++s) acc -= L[t * P + s] * X[s * P + c]; X[t * P + c] = acc; } }
        __syncthreads();
        for (int i = tid; i < 64 * 64; i += NTHREADS) { const int t = i >> 6, c = i & 63; float acc = U[t * P + c];
            for (int kk = 0; kk < 64; ++kk) acc -= W[t * P + kk] * S[kk * 64 + c];
            U[t * P + c] = acc; }
        __syncthreads();
        for (int i = tid; i < 64 * 64; i += NTHREADS) { const int t = i >> 6, c = i & 63; float acc = 0.f; const float eb = __expf(bc[t]);
            for (int kk = 0; kk < 64; ++kk) acc += q[t * P + kk] * eb * S[kk * 64 + c];
            for (int s = 0; s <= t; ++s) acc += at[t * P + s] * U[s * P + c];
            L[t * P + c] = acc; }
        __syncthreads();
        for (int i = tid; i < 64 * 64; i += NTHREADS) { const int kk = i >> 6, c = i & 63; const float bl = bc[63]; float acc = __expf(bl) * S[i];
            for (int s = 0; s < 64; ++s) acc += k[s * P + kk] * __expf(bl - bc[s]) * U[s * P + c];
            S[i] = acc; }
        if (tid < 64) { float s2 = 0.f; for (int c = 0; c < 64; ++c) s2 += L[tid * P + c] * L[tid * P + c]; rinv[tid] = 1.0f / sqrtf(s2 * (1.0f / 64) + NORM_EPS); }
        __syncthreads();
        for (int i = tid; i < 64 * 64; i += NTHREADS) { const int t = i >> 6, c = i & 63; const float z = bf2f(proj[(t0 + t) * NP + base + 192 + c]);
            y[(t0 + t) * D + ycol + c] = (bf16)f2bf(L[t * P + c] * rinv[t] * gain[c] * siluf_(z)); }
    }
}
#define XB_TMO      128
#define XB_XCNT(j)  (256  + 64 * (j))
#define XB_XSUB(j)  (1280 + 64 * (j))
#define XB_XGEN(j)  (2304 + 64 * (j))
#define XB_TOP      3328
#define XB_TOPGEN   3392
#define XCD_BAR_WORDS 3456
#define XB_SPIN_CAP (1u << 18)

__device__ __forceinline__ unsigned xb_ld(unsigned* p)              { return __hip_atomic_load(p, __ATOMIC_RELAXED, __HIP_MEMORY_SCOPE_AGENT); }
__device__ __forceinline__ unsigned xb_add(unsigned* p, unsigned v) { return __hip_atomic_fetch_add(p, v, __ATOMIC_RELAXED, __HIP_MEMORY_SCOPE_AGENT); }
__device__ __forceinline__ unsigned xb_xcc_id() { return (unsigned)__builtin_amdgcn_s_getreg((3 << 11) | 20) & 0xFu; }
#define XB_SPIN(cond, bar) do { unsigned _sp = 0; while (cond) { __builtin_amdgcn_s_sleep(1); \
    if ((++_sp & 255u) == 0u) { if (xb_ld(&(bar)[XB_TMO])) break; if (_sp > XB_SPIN_CAP) { atomicAdd(&(bar)[XB_TMO], 1u); break; } } } } while (0)

struct XcdBarrier {
    unsigned* bar; unsigned x;
    volatile LAS unsigned* st;
};

__device__ __forceinline__ XcdBarrier xcd_barrier_post(unsigned* bar, volatile LAS unsigned* st) {
    XcdBarrier b; b.bar = bar; b.x = xb_xcc_id(); b.st = st;
    if (threadIdx.x == 0) (void)xb_add(&bar[XB_XCNT(b.x)], 1u);
    return b;
}
__device__ __forceinline__ void xcd_barrier_complete(unsigned* bar, unsigned x, unsigned& nloc, unsigned& nx) {
    const unsigned G = gridDim.x * gridDim.y * gridDim.z;
    unsigned sum, cnt, mine, sp = 0u;
    for (;;) {
        sum = 0u; cnt = 0u; mine = 0u;
#pragma unroll
        for (unsigned j = 0; j < 16; ++j) { const unsigned c = xb_ld(&bar[XB_XCNT(j)]); sum += c; cnt += (c > 0u) ? 1u : 0u; mine = (j == x) ? c : mine; }
        if (sum == G) break;
        __builtin_amdgcn_s_sleep(1);
        if ((++sp & 255u) == 0u) { if (xb_ld(&bar[XB_TMO])) break; if (sp > XB_SPIN_CAP) { atomicAdd(&bar[XB_TMO], 1u); break; } }
    }
    nloc = mine > 0u ? mine : 1u; nx = cnt > 0u ? cnt : 1u;
}

__device__ __forceinline__ void xcd_barrier(const XcdBarrier& b) {
    asm volatile("s_waitcnt vmcnt(0)" ::: "memory");
    __syncthreads();
    if (threadIdx.x == 0) {
        unsigned* bar = b.bar;
        __builtin_amdgcn_s_waitcnt(0);
        unsigned nloc = b.st[0], nx = b.st[1];
        if (nloc == 0u) { xcd_barrier_complete(bar, b.x, nloc, nx); b.st[0] = nloc; b.st[1] = nx; }
        const unsigned old = xb_add(&bar[XB_XSUB(b.x)], 1u);
        const unsigned gen = old / nloc;
        if (old + 1u == (gen + 1u) * nloc) {
            __builtin_amdgcn_fence(__ATOMIC_RELEASE, "agent");
            asm volatile("s_waitcnt vmcnt(0)" ::: "memory");
            const unsigned og = xb_add(&bar[XB_TOP], 1u);
            const unsigned tg = og / nx;
            if (og + 1u == (tg + 1u) * nx) xb_add(&bar[XB_TOPGEN], 1u);
            else XB_SPIN(xb_ld(&bar[XB_TOPGEN]) == tg, bar);
            __builtin_amdgcn_fence(__ATOMIC_ACQUIRE, "agent");
            xb_add(&bar[XB_XGEN(b.x)], 1u);
            asm volatile("s_waitcnt vmcnt(0)" ::: "memory");
        } else {
            XB_SPIN(xb_ld(&bar[XB_XGEN(b.x)]) == gen, bar);
            __builtin_amdgcn_fence(__ATOMIC_ACQUIRE, "agent");
            asm volatile("s_waitcnt vmcnt(0)" ::: "memory");
        }
    }
    __syncthreads();
}

typedef _Float16 half8 __attribute__((ext_vector_type(8)));
typedef _Float16 half4 __attribute__((ext_vector_type(4)));
typedef short bfr8 __attribute__((ext_vector_type(8)));
constexpr int RS = 72;
constexpr int TILEB = 64 * RS * 2;
#define LDS_AT(T, off) (*(LAS T*)(L + (off)))
__device__ __forceinline__ f32x4 mfma32h(half8 a, half8 b, f32x4 c) { return __builtin_amdgcn_mfma_f32_16x16x32_f16(a, b, c, 0, 0, 0); }
__device__ __forceinline__ f32x4 mfma16h(half4 a, half4 b, f32x4 c) { return __builtin_amdgcn_mfma_f32_16x16x16f16(a, b, c, 0, 0, 0); }
__device__ __forceinline__ half4 to_h4(f32x4 x) { half4 r; r[0] = (_Float16)x[0]; r[1] = (_Float16)x[1]; r[2] = (_Float16)x[2]; r[3] = (_Float16)x[3]; return r; }
__device__ __forceinline__ half8 acc2op(f32x4 x0, f32x4 x1) { half8 r; r[0] = (_Float16)x0[0]; r[1] = (_Float16)x0[1]; r[2] = (_Float16)x0[2]; r[3] = (_Float16)x0[3];
    r[4] = (_Float16)x1[0]; r[5] = (_Float16)x1[1]; r[6] = (_Float16)x1[2]; r[7] = (_Float16)x1[3]; return r; }
__device__ __forceinline__ int swz8(int row) { return 8 * ((row >> 3) & 7); }
__device__ __forceinline__ half8 frag_std(LAS unsigned char* L, int tile, int row, int kb, int q, int sw) { return LDS_AT(half8, tile + row * (RS * 2) + (((32 * kb + 8 * q) ^ sw) * 2)); }
__device__ __forceinline__ half8 frag_perm(LAS unsigned char* L, int tile, int row, int kb, int q, int sw) {
    const half4 lo = LDS_AT(half4, tile + row * (RS * 2) + (((32 * kb + 4 * q) ^ sw) * 2)), hi = LDS_AT(half4, tile + row * (RS * 2) + (((32 * kb + 16 + 4 * q) ^ sw) * 2));
    half8 r; r[0] = lo[0]; r[1] = lo[1]; r[2] = lo[2]; r[3] = lo[3]; r[4] = hi[0]; r[5] = hi[1]; r[6] = hi[2]; r[7] = hi[3]; return r; }
__device__ __forceinline__ float h2f_lo(unsigned w) { return (float)__builtin_bit_cast(_Float16, (unsigned short)(w & 0xffffu)); }
__device__ __forceinline__ float h2f_hi(unsigned w) { return (float)__builtin_bit_cast(_Float16, (unsigned short)(w >> 16)); }
__device__ __forceinline__ float fsilu_(float x) { return x * __builtin_amdgcn_rcpf(1.0f + __expf(-x)); }
__device__ __forceinline__ float fsigmoid_(float x) { return __builtin_amdgcn_rcpf(1.0f + __expf(-x)); }
template <int CTRL, int RMASK, bool BOUND> __device__ __forceinline__ float dppmov(float x) { return __builtin_bit_cast(float, __builtin_amdgcn_update_dpp(0, __builtin_bit_cast(int, x), CTRL, RMASK, 0xf, BOUND)); }
__device__ __forceinline__ float wave_incl_scan(float x) {
    x += dppmov<0x111, 0xf, true>(x); x += dppmov<0x112, 0xf, true>(x); x += dppmov<0x114, 0xf, true>(x); x += dppmov<0x118, 0xf, true>(x);
    x += dppmov<0x142, 0xa, false>(x);
    x += dppmov<0x143, 0xc, false>(x);
    return x; }
__device__ __forceinline__ float lane_val(float x, int l) { return __builtin_bit_cast(float, __builtin_amdgcn_readlane(__builtin_bit_cast(int, x), l)); }
typedef const __attribute__((address_space(4))) float* cfloatp;
#define WG_BAR() do { asm volatile("s_waitcnt lgkmcnt(0)" ::: "memory"); __builtin_amdgcn_s_barrier(); asm volatile("" ::: "memory"); } while (0)

__device__ __forceinline__ void mix_gdn_fast(const Args& a, int layer, int b, int h, LAS unsigned char* L) {
    constexpr int O_K = 0, O_Q = TILEB, O_KT = 2 * TILEB, O_VB = 3 * TILEB, O_G = 4 * TILEB, O_AT = 5 * TILEB, O_OB = 6 * TILEB, OBS = 68;
    constexpr int O_VEC = O_OB + 64 * OBS * 4;
    constexpr int V_BC = O_VEC, V_EB = O_VEC + 256, V_CB = O_VEC + 512, V_DB = O_VEC + 768, V_BE = O_VEC + 1024, V_D = O_VEC + 1280;
    constexpr int O_CW = O_VEC + 1536;
    int tid0 = threadIdx.x; asm volatile("" : "+v"(tid0));
    const bf16* proj = (const bf16*)(a.ws + WS_PROJ);
    bf16* y = (bf16*)(a.ws + WS_HY);
    const int base = C_BASE + 256 * h, ycol = 640 + 64 * h;
    const float* gain = a.in[I_GC] + layer * 64;
    const float expA = __expf(a.in[I_ALOG][layer * 6 + h]), dtb = a.in[I_DTB][layer * 6 + h];
    for (int i = tid0; i < 2 * TILEB / 16; i += NTHREADS) LDS_AT(u32x4, O_G + 16 * i) = (u32x4){0u, 0u, 0u, 0u};
    for (int i = tid0; i < 768; i += NTHREADS) { const int j = i / 192, cc = i % 192, seg = cc >> 6, c = cc & 63; LDS_AT(float, O_CW + 4 * i) = a.in[I_CONV][(size_t)layer * 4 * 1152 + j * 1152 + seg * 384 + h * 64 + c]; }
    f32x4 S[4];
#pragma unroll
    for (int i = 0; i < 4; ++i) S[i] = (f32x4){0.f, 0.f, 0.f, 0.f};
    u32x4 raw[3][4]; u32x4 zraw, zprev = (u32x4){0u, 0u, 0u, 0u}; unsigned short ga = 0, gb = 0;
    const size_t tok0 = (size_t)b * SEQ;
#define GDN_PREFETCH(n_) do { const int tt_ = tid0 >> 3, cg_ = tid0 & 7; \
        _Pragma("unroll") for (int j_ = 0; j_ < 4; ++j_) { const int p_ = (n_) * 64 + tt_ - 3 + j_; \
            _Pragma("unroll") for (int s_ = 0; s_ < 3; ++s_) raw[s_][j_] = p_ >= 0 ? *(const u32x4*)(proj + (tok0 + p_) * NP + base + s_ * 64 + 8 * cg_) : (u32x4){0u, 0u, 0u, 0u}; } \
        zraw = *(const u32x4*)(proj + (tok0 + (n_) * 64 + tt_) * NP + base + 192 + 8 * cg_); \
        ga = proj[(tok0 + (n_) * 64 + (tid0 & 63)) * NP + AC_COL + h]; gb = proj[(tok0 + (n_) * 64 + (tid0 & 63)) * NP + BC_COL + h]; } while (0)
    GDN_PREFETCH(0);
    WG_BAR();
#pragma unroll 1
    for (int n = 0; n <= NCHUNK; ++n) {
        int tid = tid0; asm volatile("" : "+v"(tid));
        const int lane = tid & 63, wv = __builtin_amdgcn_readfirstlane(tid >> 6), t = tid >> 3, cg = tid & 7;
        if (n > 0) {
            const f32x4 o0 = LDS_AT(f32x4, O_OB + (t * OBS + 8 * cg) * 4), o1 = LDS_AT(f32x4, O_OB + (t * OBS + 8 * cg + 4) * 4);
            float s2 = (o0[0] * o0[0] + o0[1] * o0[1]) + (o0[2] * o0[2] + o0[3] * o0[3]) + (o1[0] * o1[0] + o1[1] * o1[1]) + (o1[2] * o1[2] + o1[3] * o1[3]);
            s2 += __shfl_xor(s2, 1); s2 += __shfl_xor(s2, 2); s2 += __shfl_xor(s2, 4);
            const float rinv = __builtin_amdgcn_rsqf(s2 * (1.0f / 64) + NORM_EPS);
            const f32x4 g0 = *(const f32x4*)(gain + 8 * cg), g1 = *(const f32x4*)(gain + 8 * cg + 4);
            u32x4 w;
            w.x = pk2(o0[0] * rinv * g0[0] * fsilu_(h2f_lo(zprev.x)), o0[1] * rinv * g0[1] * fsilu_(h2f_hi(zprev.x)));
            w.y = pk2(o0[2] * rinv * g0[2] * fsilu_(h2f_lo(zprev.y)), o0[3] * rinv * g0[3] * fsilu_(h2f_hi(zprev.y)));
            w.z = pk2(o1[0] * rinv * g1[0] * fsilu_(h2f_lo(zprev.z)), o1[1] * rinv * g1[1] * fsilu_(h2f_hi(zprev.z)));
            w.w = pk2(o1[2] * rinv * g1[2] * fsilu_(h2f_lo(zprev.w)), o1[3] * rinv * g1[3] * fsilu_(h2f_hi(zprev.w)));
            *(u32x4*)(y + (tok0 + (size_t)(n - 1) * 64 + t) * D + ycol + 8 * cg) = w;
        }
        if (n == NCHUNK) break;
        {
            const float gx = bf2f(ga) + dtb, la = -expA * (fmaxf(gx, 0.f) + __logf(1.0f + __expf(-fabsf(gx)))), beta_l = fsigmoid_(bf2f(gb));
            const float bcv = wave_incl_scan(la);
            const float bl = lane_val(bcv, 63);
            const float beta_t = __shfl(beta_l, t);
            if (wv == 0) { const float e = __expf(bcv); LDS_AT(float, V_BC + 4 * lane) = bcv; LDS_AT(float, V_EB + 4 * lane) = e; LDS_AT(float, V_CB + 4 * lane) = beta_l * e;
                LDS_AT(float, V_DB + 4 * lane) = __expf(bl - bcv); LDS_AT(float, V_BE + 4 * lane) = beta_l; if (lane == 0) LDS_AT(float, V_D) = __expf(bl); }
            float cv[3][8];
#pragma unroll
            for (int s = 0; s < 3; ++s) {
#pragma unroll
                for (int i = 0; i < 8; ++i) cv[s][i] = 0.f;
#pragma unroll
                for (int j = 0; j < 4; ++j) {
                    const f32x4 w0 = LDS_AT(f32x4, O_CW + (j * 192 + s * 64 + 8 * cg) * 4), w1 = LDS_AT(f32x4, O_CW + (j * 192 + s * 64 + 8 * cg + 4) * 4);
                    const u32x4 r = raw[s][j];
                    cv[s][0] += w0[0] * h2f_lo(r.x); cv[s][1] += w0[1] * h2f_hi(r.x); cv[s][2] += w0[2] * h2f_lo(r.y); cv[s][3] += w0[3] * h2f_hi(r.y);
                    cv[s][4] += w1[0] * h2f_lo(r.z); cv[s][5] += w1[1] * h2f_hi(r.z); cv[s][6] += w1[2] * h2f_lo(r.w); cv[s][7] += w1[3] * h2f_hi(r.w);
                }
#pragma unroll
                for (int i = 0; i < 8; ++i) cv[s][i] = fsilu_(cv[s][i]);
            }
            float sq = 0.f, sk = 0.f;
#pragma unroll
            for (int i = 0; i < 8; ++i) { sq += cv[0][i] * cv[0][i]; sk += cv[1][i] * cv[1][i]; }
            sq += __shfl_xor(sq, 1); sq += __shfl_xor(sq, 2); sq += __shfl_xor(sq, 4);
            sk += __shfl_xor(sk, 1); sk += __shfl_xor(sk, 2); sk += __shfl_xor(sk, 4);
            const float nq = 0.125f * __builtin_amdgcn_rsqf(sq + NORM_EPS), nk = __builtin_amdgcn_rsqf(sk + NORM_EPS);
            u32x4 wq, wk;
            wq.x = pk2(cv[0][0] * nq, cv[0][1] * nq); wq.y = pk2(cv[0][2] * nq, cv[0][3] * nq); wq.z = pk2(cv[0][4] * nq, cv[0][5] * nq); wq.w = pk2(cv[0][6] * nq, cv[0][7] * nq);
            wk.x = pk2(cv[1][0] * nk, cv[1][1] * nk); wk.y = pk2(cv[1][2] * nk, cv[1][3] * nk); wk.z = pk2(cv[1][4] * nk, cv[1][5] * nk); wk.w = pk2(cv[1][6] * nk, cv[1][7] * nk);
            LDS_AT(u32x4, O_Q + t * (RS * 2) + 16 * cg) = wq;
            LDS_AT(u32x4, O_K + t * (RS * 2) + 16 * cg) = wk;
            const int pc = (t ^ (8 * cg)) * 2;
#pragma unroll
            for (int i = 0; i < 8; ++i) {
                LDS_AT(unsigned short, O_KT + (8 * cg + i) * (RS * 2) + pc) = (unsigned short)f2bf(cv[1][i] * nk);
                LDS_AT(unsigned short, O_VB + (8 * cg + i) * (RS * 2) + pc) = (unsigned short)f2bf(cv[2][i] * beta_t);
            }
            zprev = zraw;
        }
        if (n + 1 < NCHUNK) GDN_PREFETCH(n + 1);
        WG_BAR();
        {
            const int m = lane & 15, q = lane >> 4;
            if (wv < 4) {
                const int i = wv, r0 = 16 * i;
                const half8 kf0 = frag_std(L, O_K, r0 + m, 0, q, 0), kf1 = frag_std(L, O_K, r0 + m, 1, q, 0);
                const half8 qf0 = frag_std(L, O_Q, r0 + m, 0, q, 0), qf1 = frag_std(L, O_Q, r0 + m, 1, q, 0);
                f32x4 kk = mfma32h(kf0, kf0, (f32x4){0.f, 0.f, 0.f, 0.f}); kk = mfma32h(kf1, kf1, kk);
                f32x4 qk = mfma32h(kf0, qf0, (f32x4){0.f, 0.f, 0.f, 0.f}); qk = mfma32h(kf1, qf1, qk);
                const float bc_n = LDS_AT(float, V_BC + 4 * (r0 + m)), be_n = LDS_AT(float, V_BE + 4 * (r0 + m));
                const f32x4 bc_r = LDS_AT(f32x4, V_BC + 4 * (r0 + 4 * q)), be_r = LDS_AT(f32x4, V_BE + 4 * (r0 + 4 * q));
                f32x4 Lc, Ltc, Pc, Ptc, atv;
#pragma unroll
                for (int r = 0; r < 4; ++r) { const int rr = 4 * q + r;
                    const float e_rn = __expf(fminf(bc_r[r] - bc_n, 0.f)), e_nr = __expf(fminf(bc_n - bc_r[r], 0.f));
                    Lc[r] = (m < rr) ? be_r[r] * kk[r] * e_rn : 0.f;
                    Ltc[r] = (rr < m) ? be_n * kk[r] * e_nr : 0.f;
                    atv[r] = (rr <= m) ? qk[r] * e_nr : 0.f;
                    const float id = (rr == m) ? 1.f : 0.f; Pc[r] = id - Lc[r]; Ptc[r] = id - Ltc[r]; }
                const f32x4 Z = (f32x4){0.f, 0.f, 0.f, 0.f};
                const half4 hM = to_h4(Lc), hMt = to_h4(Ltc), hPt = to_h4(Ptc);
                const f32x4 M2 = mfma16h(hMt, hM, Z), M2t = mfma16h(hM, hMt, Z);
                const half4 hM2 = to_h4(M2), hM2t = to_h4(M2t);
                const f32x4 P2t = mfma16h(hM2, hPt, Ptc);
                const f32x4 M4 = mfma16h(hM2t, hM2, Z), M4t = mfma16h(hM2, hM2t, Z);
                const half4 hM4 = to_h4(M4), hM4t = to_h4(M4t), hP2t = to_h4(P2t);
                const f32x4 P3t = mfma16h(hM4, hP2t, P2t);
                const f32x4 M8 = mfma16h(hM4t, hM4, Z);
                const half4 hM8 = to_h4(M8), hP3t = to_h4(P3t);
                const f32x4 Dt = mfma16h(hM8, hP3t, P3t);
                (void)Pc;
                LDS_AT(half4, O_G + (r0 + m) * (RS * 2) + (r0 + 4 * q) * 2) = to_h4(Dt);
                LDS_AT(half4, O_AT + (r0 + m) * (RS * 2) + (r0 + 4 * q) * 2) = to_h4(atv);
            } else {
#pragma unroll
                for (int rep = 0; rep < 2; ++rep) {
                    int ti, tj;
                    if (rep == 0) { ti = wv == 4 ? 1 : wv == 7 ? 3 : 2; tj = wv == 6 ? 1 : 0; }
                    else { if (wv >= 6) break; ti = 3; tj = wv == 4 ? 1 : 2; }
                    const half8 kj0 = frag_std(L, O_K, 16 * tj + m, 0, q, 0), kj1 = frag_std(L, O_K, 16 * tj + m, 1, q, 0);
                    const half8 ki0 = frag_std(L, O_K, 16 * ti + m, 0, q, 0), ki1 = frag_std(L, O_K, 16 * ti + m, 1, q, 0);
                    const half8 qi0 = frag_std(L, O_Q, 16 * ti + m, 0, q, 0), qi1 = frag_std(L, O_Q, 16 * ti + m, 1, q, 0);
                    f32x4 kk = mfma32h(kj0, ki0, (f32x4){0.f, 0.f, 0.f, 0.f}); kk = mfma32h(kj1, ki1, kk);
                    f32x4 qk = mfma32h(kj0, qi0, (f32x4){0.f, 0.f, 0.f, 0.f}); qk = mfma32h(kj1, qi1, qk);
                    const float bc_t = LDS_AT(float, V_BC + 4 * (16 * ti + m)), be_t = LDS_AT(float, V_BE + 4 * (16 * ti + m));
                    const f32x4 bc_s = LDS_AT(f32x4, V_BC + 4 * (16 * tj + 4 * q));
                    f32x4 gv, av;
#pragma unroll
                    for (int r = 0; r < 4; ++r) { const float e = __expf(fminf(bc_t - bc_s[r], 0.f)); gv[r] = -be_t * kk[r] * e; av[r] = qk[r] * e; }
                    LDS_AT(half4, O_G + (16 * ti + m) * (RS * 2) + (16 * tj + 4 * q) * 2) = to_h4(gv);
                    LDS_AT(half4, O_AT + (16 * ti + m) * (RS * 2) + (16 * tj + 4 * q) * 2) = to_h4(av);
                }
            }
        }
        WG_BAR();
        if (wv < 4) {
            const int m = lane & 15, q = lane >> 4, c = wv;
            const f32x4 Z = (f32x4){0.f, 0.f, 0.f, 0.f};
            const half8 Sop0 = acc2op(S[0], S[1]), Sop1 = acc2op(S[2], S[3]);
            const int vrow = 16 * c + m, vsw = swz8(vrow);
            f32x4 rr[4];
#pragma unroll
            for (int rt = 0; rt < 4; ++rt) {
                f32x4 acc = mfma32h(frag_perm(L, O_K, 16 * rt + m, 0, q, 0), Sop0, Z); acc = mfma32h(frag_perm(L, O_K, 16 * rt + m, 1, q, 0), Sop1, acc);
                const half4 vb = LDS_AT(half4, O_VB + vrow * (RS * 2) + (((16 * rt + 4 * q) ^ vsw) * 2));
                const f32x4 cb = LDS_AT(f32x4, V_CB + 4 * (16 * rt + 4 * q));
#pragma unroll
                for (int r = 0; r < 4; ++r) rr[rt][r] = (float)vb[r] - cb[r] * acc[r];
            }
            const half8 g00 = frag_perm(L, O_G, 0 + m, 0, q, 0), g10 = frag_perm(L, O_G, 16 + m, 0, q, 0), g20 = frag_perm(L, O_G, 32 + m, 0, q, 0), g21 = frag_perm(L, O_G, 32 + m, 1, q, 0),
                        g30 = frag_perm(L, O_G, 48 + m, 0, q, 0), g31 = frag_perm(L, O_G, 48 + m, 1, q, 0);
            const f32x4 v0 = mfma32h(g00, acc2op(rr[0], Z), Z);
            const f32x4 a1 = mfma32h(g10, acc2op(v0, Z), rr[1]);
            const f32x4 v1 = mfma32h(g10, acc2op(Z, a1), Z);
            const half8 v01 = acc2op(v0, v1);
            const f32x4 a2 = mfma32h(g20, v01, rr[2]);
            const f32x4 v2 = mfma32h(g21, acc2op(a2, Z), Z);
            f32x4 a3 = mfma32h(g30, v01, rr[3]); a3 = mfma32h(g31, acc2op(v2, Z), a3);
            const f32x4 v3 = mfma32h(g31, acc2op(Z, a3), Z);
            const half8 v23 = acc2op(v2, v3);
#pragma unroll
            for (int rt = 0; rt < 4; ++rt) {
                f32x4 acc = mfma32h(frag_perm(L, O_Q, 16 * rt + m, 0, q, 0), Sop0, Z); acc = mfma32h(frag_perm(L, O_Q, 16 * rt + m, 1, q, 0), Sop1, acc);
                const f32x4 eb = LDS_AT(f32x4, V_EB + 4 * (16 * rt + 4 * q));
                acc = acc * eb;
                acc = mfma32h(frag_perm(L, O_AT, 16 * rt + m, 0, q, 0), v01, acc);
                if (rt >= 2) acc = mfma32h(frag_perm(L, O_AT, 16 * rt + m, 1, q, 0), v23, acc);
#pragma unroll
                for (int r = 0; r < 4; ++r) LDS_AT(float, O_OB + ((16 * rt + 4 * q + r) * OBS + 16 * c + m) * 4) = acc[r];
            }
            const f32x4 db0 = LDS_AT(f32x4, V_DB + 4 * (4 * q)), db1 = LDS_AT(f32x4, V_DB + 4 * (16 + 4 * q)), db2 = LDS_AT(f32x4, V_DB + 4 * (32 + 4 * q)), db3 = LDS_AT(f32x4, V_DB + 4 * (48 + 4 * q));
            const half8 w01 = acc2op(v0 * db0, v1 * db1), w23 = acc2op(v2 * db2, v3 * db3);
            const float dsc = LDS_AT(float, V_D);
#pragma unroll
            for (int rt = 0; rt < 4; ++rt) { const int krow = 16 * rt + m, ksw = swz8(krow);
                f32x4 acc = S[rt] * dsc;
                acc = mfma32h(frag_perm(L, O_KT, krow, 0, q, ksw), w01, acc); acc = mfma32h(frag_perm(L, O_KT, krow, 1, q, ksw), w23, acc);
                S[rt] = acc; }
        }
        WG_BAR();
    }
#undef GDN_PREFETCH
}

__device__ __forceinline__ unsigned pk2b(float lo, float hi) { unsigned r; asm volatile("v_cvt_pk_bf16_f32 %0, %1, %2" : "=v"(r) : "v"(lo), "v"(hi)); return r; }
__device__ __forceinline__ f32x4 mfma32b(bfr8 a, bfr8 b, f32x4 c) { return __builtin_amdgcn_mfma_f32_16x16x32_bf16(a, b, c, 0, 0, 0); }
template <int DK, int DV, bool ISA>
__device__ __forceinline__ void mix_gla_fast(const Args& a, int layer, int b, int h, LAS unsigned char* L) {
    constexpr int O_QS = 0, O_KV = TILEB, O_P = O_KV + TILEB, O_QT = O_P + TILEB, O_KST = O_QT + TILEB, O_VT = O_KST + TILEB, O_OB = O_VT + DV * RS * 2, OBS = DV + 4;
    constexpr int V_DS = O_OB + 64 * OBS * 4, O_WG = V_DS + 256  , LDS_END = O_WG + 17 * 48 * 4;
    static_assert(LDS_END <= LDS_BYTES, "GLA LDS map");
    constexpr int NGW = DK / 8;
    constexpr int NG2 = DV / 8 - 8;
    int tid0 = threadIdx.x; asm volatile("" : "+v"(tid0));
    const bf16* proj = (const bf16*)(a.ws + WS_PROJ);
    bf16* y = (bf16*)(a.ws + WS_HY);
    const int base = ISA ? A_BASE + 256 * h : B_BASE + 288 * h;
    const int vcol = ISA ? base + 128 : base + 96, zcol = base + 192, ycol = ISA ? 64 * h : 256 + 96 * h;
    const float* gain = ISA ? a.in[I_GA] + layer * 64 : a.in[I_GB] + layer * 96;
    const float* lb = (const float*)(a.ws + WS_LB) + layer * 256 + h * 64;
    const float* wgk = a.in[I_WGK] + (size_t)layer * 16 * 192 + h * 48;
    const float* bgk = a.in[I_BGK] + layer * 192 + h * 48;
    for (int i = tid0; i < O_OB / 16; i += NTHREADS) LDS_AT(u32x4, 16 * i) = (u32x4){0u, 0u, 0u, 0u};
    if (tid0 < 64) LDS_AT(float, V_DS + 4 * tid0) = 1.f;
    if (!ISA) for (int i = tid0; i < 17 * 48; i += NTHREADS) { const int r = i / 48, c = i % 48; LDS_AT(float, O_WG + 4 * i) = r < 16 ? wgk[r * 192 + c] : bgk[c]; }
    f32x4 S[4];
#pragma unroll
    for (int i = 0; i < 4; ++i) S[i] = (f32x4){0.f, 0.f, 0.f, 0.f};
    const u32x4 Z4 = (u32x4){0u, 0u, 0u, 0u};
    u32x4 qraw = Z4, fraw = Z4, lr0 = Z4, lr1 = Z4, vraw = Z4, vraw2 = Z4, zraw = Z4, zraw2 = Z4, zprev = Z4, zprev2 = Z4;
    const size_t tok0 = (size_t)b * SEQ;
#define GLA_PREFETCH(n_) do { const int w_ = tid0 >> 6, ln_ = tid0 & 63, tv_ = tid0 >> 3, pt_ = tid0 & 7; \
        if (w_ < NGW) { const bf16* row_ = proj + (tok0 + (n_) * 64 + ln_) * NP; qraw = *(const u32x4*)(row_ + base + 8 * w_); fraw = *(const u32x4*)(row_ + base + (ISA ? 64 : 48) + 8 * w_); \
            if (!ISA) { lr0 = *(const u32x4*)(row_ + LR_COL); lr1 = *(const u32x4*)(row_ + LR_COL + 8); } } \
        { const bf16* row_ = proj + (tok0 + (n_) * 64 + tv_) * NP; vraw = *(const u32x4*)(row_ + vcol + 8 * pt_); zraw = *(const u32x4*)(row_ + zcol + 8 * pt_); \
            if (NG2 > 0 && pt_ < NG2) { vraw2 = *(const u32x4*)(row_ + vcol + 64 + 8 * pt_); zraw2 = *(const u32x4*)(row_ + zcol + 64 + 8 * pt_); } } } while (0)
    GLA_PREFETCH(0);
    WG_BAR();
#pragma unroll 1
    for (int n = 0; n <= NCHUNK; ++n) {
        int tid = tid0; asm volatile("" : "+v"(tid));
        const int lane = tid & 63, wv = __builtin_amdgcn_readfirstlane(tid >> 6), tv = tid >> 3, pt = tid & 7;
        if (n > 0) {
            const f32x4 o0 = LDS_AT(f32x4, O_OB + (tv * OBS + 8 * pt) * 4), o1 = LDS_AT(f32x4, O_OB + (tv * OBS + 8 * pt + 4) * 4);
            f32x4 o2 = (f32x4){0.f, 0.f, 0.f, 0.f}, o3 = o2;
            if (NG2 > 0 && pt < NG2) { o2 = LDS_AT(f32x4, O_OB + (tv * OBS + 64 + 8 * pt) * 4); o3 = LDS_AT(f32x4, O_OB + (tv * OBS + 64 + 8 * pt + 4) * 4); }
            float s2 = (o0[0] * o0[0] + o0[1] * o0[1]) + (o0[2] * o0[2] + o0[3] * o0[3]) + (o1[0] * o1[0] + o1[1] * o1[1]) + (o1[2] * o1[2] + o1[3] * o1[3]);
            s2 += (o2[0] * o2[0] + o2[1] * o2[1]) + (o2[2] * o2[2] + o2[3] * o2[3]) + (o3[0] * o3[0] + o3[1] * o3[1]) + (o3[2] * o3[2] + o3[3] * o3[3]);
            s2 += __shfl_xor(s2, 1); s2 += __shfl_xor(s2, 2); s2 += __shfl_xor(s2, 4);
            const float rinv = __builtin_amdgcn_rsqf(s2 * (1.0f / DV) + NORM_EPS);
            bf16* yrow = y + (tok0 + (size_t)(n - 1) * 64 + tv) * D + ycol;
            { const f32x4 g0 = *(const f32x4*)(gain + 8 * pt), g1 = *(const f32x4*)(gain + 8 * pt + 4); u32x4 w;
              w.x = pk2(o0[0] * rinv * g0[0] * fsilu_(h2f_lo(zprev.x)), o0[1] * rinv * g0[1] * fsilu_(h2f_hi(zprev.x)));
              w.y = pk2(o0[2] * rinv * g0[2] * fsilu_(h2f_lo(zprev.y)), o0[3] * rinv * g0[3] * fsilu_(h2f_hi(zprev.y)));
              w.z = pk2(o1[0] * rinv * g1[0] * fsilu_(h2f_lo(zprev.z)), o1[1] * rinv * g1[1] * fsilu_(h2f_hi(zprev.z)));
              w.w = pk2(o1[2] * rinv * g1[2] * fsilu_(h2f_lo(zprev.w)), o1[3] * rinv * g1[3] * fsilu_(h2f_hi(zprev.w)));
              *(u32x4*)(yrow + 8 * pt) = w; }
            if (NG2 > 0 && pt < NG2) { const f32x4 g0 = *(const f32x4*)(gain + 64 + 8 * pt), g1 = *(const f32x4*)(gain + 64 + 8 * pt + 4); u32x4 w;
              w.x = pk2(o2[0] * rinv * g0[0] * fsilu_(h2f_lo(zprev2.x)), o2[1] * rinv * g0[1] * fsilu_(h2f_hi(zprev2.x)));
              w.y = pk2(o2[2] * rinv * g0[2] * fsilu_(h2f_lo(zprev2.y)), o2[3] * rinv * g0[3] * fsilu_(h2f_hi(zprev2.y)));
              w.z = pk2(o3[0] * rinv * g1[0] * fsilu_(h2f_lo(zprev2.z)), o3[1] * rinv * g1[1] * fsilu_(h2f_hi(zprev2.z)));
              w.w = pk2(o3[2] * rinv * g1[2] * fsilu_(h2f_lo(zprev2.w)), o3[3] * rinv * g1[3] * fsilu_(h2f_hi(zprev2.w)));
              *(u32x4*)(yrow + 64 + 8 * pt) = w; }
        }
        if (n == NCHUNK) break;
        if (wv < NGW) {
            float qv[8], kv[8], bc[8];
            const unsigned qw[4] = {qraw.x, qraw.y, qraw.z, qraw.w}, fw[4] = {fraw.x, fraw.y, fraw.z, fraw.w};
            if (ISA) {
                const cfloatp lbc = (cfloatp)lb;
#pragma unroll
                for (int i = 0; i < 8; ++i) { const float qr = (i & 1) ? h2f_hi(qw[i >> 1]) : h2f_lo(qw[i >> 1]), fl = (i & 1) ? h2f_hi(fw[i >> 1]) : h2f_lo(fw[i >> 1]);
                    const float lbv = lbc[8 * wv + i], e = __expf(-fmaxf(fl, -30.f)), sg = __builtin_amdgcn_rcpf(1.0f + e);
                    qv[i] = fsilu_(qr); kv[i] = (1.f - lbv) * (e * sg); bc[i] = __logf(fmaxf(lbv + (1.f - lbv) * sg, 1e-30f)); }
            } else {
                float lrv[16];
                const unsigned lw[8] = {lr0.x, lr0.y, lr0.z, lr0.w, lr1.x, lr1.y, lr1.z, lr1.w};
#pragma unroll
                for (int r = 0; r < 16; ++r) lrv[r] = (r & 1) ? h2f_hi(lw[r >> 1]) : h2f_lo(lw[r >> 1]);
                f32x4 pa = LDS_AT(f32x4, O_WG + (16 * 48 + 8 * wv) * 4), pb = LDS_AT(f32x4, O_WG + (16 * 48 + 8 * wv + 4) * 4);
#pragma unroll
                for (int r = 0; r < 16; ++r) { const f32x4 wa = LDS_AT(f32x4, O_WG + (r * 48 + 8 * wv) * 4), wb = LDS_AT(f32x4, O_WG + (r * 48 + 8 * wv + 4) * 4); pa += wa * lrv[r]; pb += wb * lrv[r]; }
                const float pre[8] = {pa[0], pa[1], pa[2], pa[3], pb[0], pb[1], pb[2], pb[3]};
#pragma unroll
                for (int i = 0; i < 8; ++i) { const float s = pre[i];
                    qv[i] = ((i & 1) ? h2f_hi(qw[i >> 1]) : h2f_lo(qw[i >> 1])) * 0.14433756729740643f; kv[i] = (i & 1) ? h2f_hi(fw[i >> 1]) : h2f_lo(fw[i >> 1]);
                    bc[i] = -(fmaxf(-s, 0.f) + __logf(1.0f + __expf(-fabsf(s)))) * (1.0f / 16.0f); }
            }
            float qs[8], qt[8], kk[8], kst[8];
#pragma unroll
            for (int i = 0; i < 8; ++i) {
                bc[i] = wave_incl_scan(bc[i]);
                const float Bmid = lane_val(bc[i], 31);
                const float e1 = __expf(fminf(bc[i] - Bmid, 80.f)), e2 = __expf(fminf(Bmid - bc[i], 80.f)), e3 = __expf(bc[i]);
                qs[i] = qv[i] * e1; kk[i] = kv[i] * e2; qt[i] = qv[i] * e3;
                kst[i] = kk[i] * lane_val(e1, 63);
                if (lane == 0) LDS_AT(float, V_DS + 4 * (8 * wv + i)) = lane_val(e3, 63);
            }
            u32x4 w;
            w.x = pk2b(qs[0], qs[1]); w.y = pk2b(qs[2], qs[3]); w.z = pk2b(qs[4], qs[5]); w.w = pk2b(qs[6], qs[7]); LDS_AT(u32x4, O_QS + lane * (RS * 2) + 16 * wv) = w;
            w.x = pk2b(kk[0], kk[1]); w.y = pk2b(kk[2], kk[3]); w.z = pk2b(kk[4], kk[5]); w.w = pk2b(kk[6], kk[7]); LDS_AT(u32x4, O_KV + lane * (RS * 2) + 16 * wv) = w;
            w.x = pk2(qt[0], qt[1]); w.y = pk2(qt[2], qt[3]); w.z = pk2(qt[4], qt[5]); w.w = pk2(qt[6], qt[7]); LDS_AT(u32x4, O_QT + lane * (RS * 2) + 16 * wv) = w;
            const int pc = (lane ^ (8 * wv)) * 2;
#pragma unroll
            for (int i = 0; i < 8; ++i) LDS_AT(unsigned short, O_KST + (8 * wv + i) * (RS * 2) + pc) = (unsigned short)f2bf(kst[i]);
        }
        {
            const unsigned vw[4] = {vraw.x, vraw.y, vraw.z, vraw.w};
            const int pc = (tv ^ (8 * pt)) * 2;
#pragma unroll
            for (int i = 0; i < 8; ++i) LDS_AT(unsigned short, O_VT + (8 * pt + i) * (RS * 2) + pc) = (unsigned short)((i & 1) ? (vw[i >> 1] >> 16) : (vw[i >> 1] & 0xffffu));
            if (NG2 > 0 && pt < NG2) { const unsigned vw2[4] = {vraw2.x, vraw2.y, vraw2.z, vraw2.w};
#pragma unroll
                for (int i = 0; i < 8; ++i) LDS_AT(unsigned short, O_VT + (64 + 8 * pt + i) * (RS * 2) + pc) = (unsigned short)((i & 1) ? (vw2[i >> 1] >> 16) : (vw2[i >> 1] & 0xffffu)); }
            zprev = zraw; zprev2 = zraw2;
        }
        if (n + 1 < NCHUNK) GLA_PREFETCH(n + 1);
        WG_BAR();
        {
            const int m = lane & 15, q = lane >> 4;
#pragma unroll
            for (int rep = 0; rep < 2; ++rep) {
                const int tix = wv + 8 * rep; if (tix >= 10) break;
                const int ti = tix == 0 ? 0 : tix <= 2 ? 1 : tix <= 5 ? 2 : 3, tj = tix - (ti * (ti + 1)) / 2;
                const bfr8 a0 = LDS_AT(bfr8, O_KV + (16 * tj + m) * (RS * 2) + (8 * q) * 2), a1 = LDS_AT(bfr8, O_KV + (16 * tj + m) * (RS * 2) + (32 + 8 * q) * 2);
                const bfr8 b0 = LDS_AT(bfr8, O_QS + (16 * ti + m) * (RS * 2) + (8 * q) * 2), b1 = LDS_AT(bfr8, O_QS + (16 * ti + m) * (RS * 2) + (32 + 8 * q) * 2);
                f32x4 p = mfma32b(a0, b0, (f32x4){0.f, 0.f, 0.f, 0.f}); p = mfma32b(a1, b1, p);
                if (ti == tj) {
#pragma unroll
                    for (int r = 0; r < 4; ++r) if (4 * q + r > m) p[r] = 0.f; }
                LDS_AT(half4, O_P + (16 * ti + m) * (RS * 2) + (16 * tj + 4 * q) * 2) = to_h4(p);
            }
        }
        WG_BAR();
        if (wv < DV / 16) {
            const int m = lane & 15, q = lane >> 4, c = wv;
            const f32x4 Z = (f32x4){0.f, 0.f, 0.f, 0.f};
            const half8 Sop0 = acc2op(S[0], S[1]), Sop1 = acc2op(S[2], S[3]);
            const int vrow = 16 * c + m, vsw = swz8(vrow);
            const half8 vf0 = frag_std(L, O_VT, vrow, 0, q, vsw), vf1 = frag_std(L, O_VT, vrow, 1, q, vsw);
#pragma unroll
            for (int rt = 0; rt < 4; ++rt) {
                f32x4 acc = mfma32h(frag_std(L, O_P, 16 * rt + m, 0, q, 0), vf0, Z);
                if (rt >= 2) acc = mfma32h(frag_std(L, O_P, 16 * rt + m, 1, q, 0), vf1, acc);
                acc = mfma32h(frag_perm(L, O_QT, 16 * rt + m, 0, q, 0), Sop0, acc); acc = mfma32h(frag_perm(L, O_QT, 16 * rt + m, 1, q, 0), Sop1, acc);
#pragma unroll
                for (int r = 0; r < 4; ++r) LDS_AT(float, O_OB + ((16 * rt + 4 * q + r) * OBS + 16 * c + m) * 4) = acc[r];
            }
#pragma unroll
            for (int rt = 0; rt < 4; ++rt) { const int krow = 16 * rt + m, ksw = swz8(krow);
                const f32x4 ds = LDS_AT(f32x4, V_DS + 4 * (16 * rt + 4 * q));
                f32x4 acc = S[rt] * ds;
                acc = mfma32h(frag_std(L, O_KST, krow, 0, q, ksw), vf0, acc); acc = mfma32h(frag_std(L, O_KST, krow, 1, q, ksw), vf1, acc);
                S[rt] = acc; }
        }
        WG_BAR();
    }
#undef GLA_PREFETCH
}
#ifndef FAST_A
#define FAST_A 0
#endif
#ifndef FAST_B
#define FAST_B 0
#endif
#ifndef FAST_C
#define FAST_C 0
#endif
__device__ __forceinline__ void p3_mixers(const Args& a, int layer, unsigned char* lds_g) {
    const int id = blockIdx.x;
    if (id < 96) {
#if FAST_C
        mix_gdn_fast(a, layer, id / 6, id % 6, (LAS unsigned char*)lds_g);
#ifdef PROBE_2C
        __syncthreads(); mix_gdn_fast(a, layer, id / 6, id % 6, (LAS unsigned char*)lds_g);
#endif
#else
        mix_gdn_base(a, layer, id / 6, id % 6, (float*)lds_g);
#endif
    } else if (id < 160) {
#if FAST_A
        mix_gla_fast<64, 64, true>(a, layer, (id - 96) >> 2, (id - 96) & 3, (LAS unsigned char*)lds_g);
#ifdef PROBE_2A
        __syncthreads(); mix_gla_fast<64, 64, true>(a, layer, (id - 96) >> 2, (id - 96) & 3, (LAS unsigned char*)lds_g);
#endif
#else
        mix_gla_base<64, 64, true>(a, layer, (id - 96) >> 2, (id - 96) & 3, (float*)lds_g);
#endif
    } else if (id < 224) {
#if FAST_B
        mix_gla_fast<48, 96, false>(a, layer, (id - 160) >> 2, (id - 160) & 3, (LAS unsigned char*)lds_g);
#ifdef PROBE_2B
        __syncthreads(); mix_gla_fast<48, 96, false>(a, layer, (id - 160) >> 2, (id - 160) & 3, (LAS unsigned char*)lds_g);
#endif
#else
        mix_gla_base<48, 96, false>(a, layer, (id - 160) >> 2, (id - 160) & 3, (float*)lds_g);
#endif
    }
}
#ifndef MK_ONE_LAUNCH
#define MK_ONE_LAUNCH 0
#endif
constexpr int N_PHASES = 10;
template <int PLO, int PHI> __global__ void __launch_bounds__(NTHREADS, 2) mega(Args args_) {
    extern __shared__ __attribute__((aligned(16))) unsigned char lds[];
#if defined(__HIP_DEVICE_COMPILE__)
#define ARGS() const Args args = *({ const __attribute__((address_space(4))) Args* ap_ = (const __attribute__((address_space(4))) Args*)__builtin_amdgcn_kernarg_segment_ptr(); asm volatile("" : "+s"(ap_)); ap_; })
#else
#define ARGS() const Args args = args_
#endif
    constexpr int lo = PLO, hi = PHI;
    XcdBarrier xbar; xbar.bar = nullptr; xbar.x = 0; xbar.st = (volatile LAS unsigned*)((LAS unsigned char*)lds + MISC_OFF);
    if (PHI - PLO > 1) {
        if (threadIdx.x < 16) ((LAS unsigned*)((LAS unsigned char*)lds + MISC_OFF))[threadIdx.x] = 0u;
        __syncthreads();
        unsigned* barw = (unsigned*)(args_.ws + WS_CTL) + CW_BAR;
        xbar = xcd_barrier_post(barw, (volatile LAS unsigned*)((LAS unsigned char*)lds + MISC_OFF));
    }
#define IN(k) (lo <= (k) && (k) < hi)
#define SEAM(k) do { if (IN(k) && IN((k) + 1)) { if ((k) == 0) cg::this_grid().sync(); else xcd_barrier(xbar); } } while (0)
#define WSP(T, off) ((T*)(args.ws + (off)))
    if (IN(0)) { ARGS(); p0_prep(args, lds); }
    SEAM(0);
    if (IN(1)) { ARGS(); ln_rows<0>(args.in[I_X], nullptr, WSP(bf16, WS_HY), nullptr, nullptr, WSP(float, WS_MOD)); }
    SEAM(1);
#pragma unroll
    for (int l = 0; l < 2; ++l) {
        const int p = 2 + 4 * l;
        if (IN(p)) { ARGS();
            pg8::Gemm g{WSP(bf16, WS_HY), WSP(bf16, WS_WIN) + (size_t)l * NP * 1024, M, NP, D}; pg8::StaticOrder S; S.init(M, NP, gridDim.x, (int)blockIdx.x);
            pg8::EpiBf16<0> E{WSP(bf16, WS_PROJ), NP, nullptr, 0, 0, 1.f};
            pg8::gemm_phase<pg8::EpiBf16<0>, pg8::StaticOrder, true, true>((PG8_LAS unsigned char*)lds, g, S, E);
        }
        SEAM(p);
        if (IN(p + 1)) { ARGS(); p3_mixers(args, l, lds);
#ifdef PROBE_MIX2
            __syncthreads(); p3_mixers(args, l, lds);
#endif
        }
        SEAM(p + 1);
        if (IN(p + 2)) { ARGS();
            const float* xin = l == 0 ? args.in[I_X] : WSP(float, WS_X1);
            pg8::Gemm g{WSP(bf16, WS_HY), WSP(bf16, WS_WOUT) + (size_t)l * 1024 * 1024, M, D, D}; pg8::StaticOrder S; S.init(M, D, gridDim.x, (int)blockIdx.x);
            EpiRes E{xin, args.out, WSP(float, WS_MOD) + (size_t)l * 16 * 3072 + 2048};
            pg8::gemm_phase<EpiRes, pg8::StaticOrder, true, true>((PG8_LAS unsigned char*)lds, g, S, E);
        }
        SEAM(p + 2);
        if (IN(p + 3)) { ARGS();
            if (l == 0) ln_rows<1>(args.out, WSP(float, WS_X1), WSP(bf16, WS_HY), args.in[I_LNG], args.in[I_LNB], WSP(float, WS_MOD) + (size_t)16 * 3072);
            else ln_rows<1>(args.out, args.out, nullptr, args.in[I_LNG] + 1024, args.in[I_LNB] + 1024, nullptr);
        }
        if (l == 0) SEAM(p + 3);
    }
#undef WSP
#undef ARGS
#undef IN
#undef SEAM
}

#include <utility>
template <int P> static hipError_t set_attr1() { return hipFuncSetAttribute((const void*)mega<P, P + 1>, hipFuncAttributeMaxDynamicSharedMemorySize, LDS_BYTES); }
template <int... P> static hipError_t set_attrs_(std::integer_sequence<int, P...>) { hipError_t e = hipSuccess; hipError_t r[] = {set_attr1<P>()...}; for (hipError_t x : r) if (x != hipSuccess) e = x; return e; }
static hipError_t set_attrs() {
#if MK_ONE_LAUNCH
    return hipFuncSetAttribute((const void*)mega<0, N_PHASES>, hipFuncAttributeMaxDynamicSharedMemorySize, LDS_BYTES);
#else
    return set_attrs_(std::make_integer_sequence<int, N_PHASES>{});
#endif
}
template <int P> static int launch1(const Args& a, int grid, hipStream_t stream) { hipLaunchKernelGGL((mega<P, P + 1>), dim3(grid), dim3(NTHREADS), LDS_BYTES, stream, a); return 0; }
template <int... P> static void launch_all(const Args& a, int grid, hipStream_t stream, std::integer_sequence<int, P...>) { int r[] = {launch1<P>(a, grid, stream)...}; (void)r; }
extern "C" void kernel_launch(void* const* d_in, const int* in_sizes, int n_in, void* d_out, int out_size, void* d_ws, size_t ws_size, hipStream_t stream) {
    static int grid = 0;
    if (grid == 0) {
        if (n_in != 17 || out_size != M * D || ws_size < WS_END) { fprintf(stderr, "kernel_launch: unexpected shapes (n_in %d out %d ws %zu)\n", n_in, out_size, ws_size); grid = -1; return; }
        if (set_attrs() != hipSuccess) { fprintf(stderr, "kernel_launch: hipFuncSetAttribute failed\n"); grid = -1; return; }
        int dev = 0, cus = 0, per_cu = 0;
        (void)hipGetDevice(&dev); (void)hipDeviceGetAttribute(&cus, hipDeviceAttributeMultiprocessorCount, dev);
#if MK_ONE_LAUNCH
        (void)hipOccupancyMaxActiveBlocksPerMultiprocessor(&per_cu, (const void*)mega<0, N_PHASES>, NTHREADS, LDS_BYTES);
#else
        per_cu = 1;
#endif
        if (per_cu < 1 || cus < 256) { fprintf(stderr, "kernel_launch: occupancy %d blocks/CU, %d CUs: cannot run\n", per_cu, cus); grid = -1; return; }
        grid = 256;
    }
    if (grid < 0) return;
    if (hipMemsetAsync((char*)d_ws + WS_CTL, 0, CTL_ZERO_BYTES, stream) != hipSuccess) { fprintf(stderr, "kernel_launch: memset of control words failed\n"); return; }
    Args a{};
    for (int i = 0; i < 17; ++i) a.in[i] = (const float*)d_in[i];
    a.out = (float*)d_out; a.ws = (unsigned char*)d_ws;
#if MK_ONE_LAUNCH
    a.ph_lo = 0; a.ph_hi = N_PHASES;
    void* kargs[] = {&a};
    hipError_t e = hipLaunchCooperativeKernel((const void*)mega<0, N_PHASES>, dim3(grid), dim3(NTHREADS), kargs, LDS_BYTES, stream);
    if (e != hipSuccess) fprintf(stderr, "kernel_launch: cooperative launch failed: %s\n", hipGetErrorString(e));
#else
    launch_all(a, grid, stream, std::make_integer_sequence<int, N_PHASES>{});
#endif
}
```
